# Optimizing an MI355X kernel written in HIP

```python
import math
import jax, jax.numpy as jnp
from jax import lax
import numpy as np

D_MODEL = 1024
BATCH = 2
SEQ = 8192
DEPTH = 2

BRANCH_WIDTH = D_MODEL // 2
A_DK = 64
A_DV = 2 * A_DK
A_HEADS = BRANCH_WIDTH // A_DV
A_QK = A_HEADS * 2 * A_DK
B_DK = 64
B_DV = 64
B_HEADS = BRANCH_WIDTH // B_DV
B_GROUPS = 2
B_HPG = B_HEADS // B_GROUPS
CMP_LEN = 32
CMP_STRIDE = 16
SLC_LEN = 64
SLC_TOPK = 16
WIN = 512
PHI_HIDDEN = 256
N_NSA_BRANCH = 3
C_WIDTH = BRANCH_WIDTH
C_WINDOWS = (2, 4, 8, 16)
C_GROUPS = len(C_WINDOWS)
C_GDIM = C_WIDTH // C_GROUPS
N_BRANCH = 3

Q_BLOCK = 128
EPS = 1e-6
NEG_INF = -1e30
BIG = 1e30

SPLIT_SIZES = (A_QK, A_QK, BRANCH_WIDTH, BRANCH_WIDTH,
               B_HEADS * B_DK, N_NSA_BRANCH * 2 * B_GROUPS * B_DK,
               B_HEADS * N_NSA_BRANCH, BRANCH_WIDTH,
               C_WIDTH, C_WIDTH,
               N_BRANCH * D_MODEL)
N_IN = sum(SPLIT_SIZES)

kernel_name = 'hybrid_diff_nsa_pool_block'


def rms_norm(x, g):
    xf = x.astype(jnp.float32)
    y = xf * lax.rsqrt(jnp.mean(xf * xf, axis=-1, keepdims=True) + EPS)
    return (y * g.astype(jnp.float32)).astype(x.dtype)


def diff_attention(q, k, v, lam):
    Bn, H, _, S, dk = q.shape
    dv = v.shape[-1]
    scale = dk ** -0.5
    key_pos = jnp.arange(S)

    def block(i):
        q0 = i * Q_BLOCK
        qb = lax.dynamic_slice_in_dim(q, q0, Q_BLOCK, axis=3)
        sc = jnp.einsum('bhmqd,bhmkd->bhmqk', qb, k).astype(jnp.float32) * scale
        qpos = q0 + jnp.arange(Q_BLOCK)
        mask = key_pos[None, :] <= qpos[:, None]
        p = jax.nn.softmax(jnp.where(mask, sc, NEG_INF), axis=-1)
        w = p[:, :, 0] - lam * p[:, :, 1]
        return jnp.einsum('bhqk,bhkd->bhqd', w.astype(v.dtype), v)

    out = lax.map(block, jnp.arange(S // Q_BLOCK))
    return out.transpose(1, 2, 0, 3, 4).reshape(Bn, H, S, dv)


def compress_blocks(kv, pos, w1, w2):
    S, d = kv.shape[2], kv.shape[3]
    nc = (S - CMP_LEN) // CMP_STRIDE + 1
    idx = np.arange(nc)[:, None] * CMP_STRIDE + np.arange(CMP_LEN)[None, :]
    blocks = kv[:, :, idx] + pos
    flat = blocks.reshape(blocks.shape[0], blocks.shape[1], nc, CMP_LEN * d)
    return jax.nn.silu(flat @ w1) @ w2


def overlap_matrix(S):
    nc = (S - CMP_LEN) // CMP_STRIDE + 1
    ns = S // SLC_LEN
    cs = np.arange(nc) * CMP_STRIDE
    ce = cs + CMP_LEN
    ss = np.arange(ns) * SLC_LEN
    se = ss + SLC_LEN
    ov = np.clip(np.minimum(ce[:, None], se[None, :]) - np.maximum(cs[:, None], ss[None, :]), 0, None)
    return jnp.asarray(ov / CMP_LEN, dtype=jnp.float32)


def nsa_attention(q, k_cmp, v_cmp, k_slc, v_slc, k_win_pad, v_win_pad, gates):
    Bn, G, Hg, S, dk = q.shape
    nc = k_cmp.shape[2]
    ns = k_slc.shape[2]
    topk = min(SLC_TOPK, ns)
    scale = dk ** -0.5
    ov = overlap_matrix(S)
    cmp_end = jnp.arange(nc) * CMP_STRIDE + CMP_LEN - 1
    blk = jnp.arange(ns)
    bi = jnp.arange(Bn)[:, None, None, None]
    gi = jnp.arange(G)[None, :, None, None]

    def block(i):
        q0 = i * Q_BLOCK
        qb = lax.dynamic_slice_in_dim(q, q0, Q_BLOCK, axis=3)
        gb = lax.dynamic_slice_in_dim(gates, q0, Q_BLOCK, axis=3)
        qpos = q0 + jnp.arange(Q_BLOCK)
        sc = jnp.einsum('bghqd,bgnd->bghqn', qb, k_cmp).astype(jnp.float32) * scale
        cmask = cmp_end[None, :] <= qpos[:, None]
        has_cmp = jnp.any(cmask, axis=-1)[:, None].astype(jnp.float32)
        p_cmp = jax.nn.softmax(jnp.where(cmask, sc, NEG_INF), axis=-1) * has_cmp
        o_cmp = jnp.einsum('bghqn,bgnd->bghqd', p_cmp.astype(v_cmp.dtype), v_cmp)
        imp = jnp.einsum('bghqn,ns->bgqs', p_cmp, ov)
        cur = (qpos // SLC_LEN)[:, None]
        forced = (blk[None, :] == 0) | (blk[None, :] == cur) | (blk[None, :] == cur - 1)
        imp = jnp.where(forced, BIG, imp)
        imp = jnp.where(blk[None, :] > cur, NEG_INF, imp)
        _, idx = lax.top_k(imp, topk)
        kb = k_slc[bi, gi, idx]
        vb = v_slc[bi, gi, idx]
        tok = idx[..., None] * SLC_LEN + jnp.arange(SLC_LEN)
        smask = (tok <= qpos[:, None, None])[:, :, None]
        ss = jnp.einsum('bghqd,bgqnld->bghqnl', qb, kb).astype(jnp.float32) * scale
        ss = jnp.where(smask, ss, NEG_INF)
        ps = jax.nn.softmax(ss.reshape(ss.shape[:4] + (-1,)), axis=-1).reshape(ss.shape)
        o_slc = jnp.einsum('bghqnl,bgqnld->bghqd', ps.astype(vb.dtype), vb)
        kw = lax.dynamic_slice_in_dim(k_win_pad, q0, Q_BLOCK + WIN, axis=2)
        vw = lax.dynamic_slice_in_dim(v_win_pad, q0, Q_BLOCK + WIN, axis=2)
        kpos = q0 - WIN + jnp.arange(Q_BLOCK + WIN)
        wmask = ((kpos[None, :] <= qpos[:, None]) & (kpos[None, :] > qpos[:, None] - WIN)
                 & (kpos[None, :] >= 0))
        sw = jnp.einsum('bghqd,bgkd->bghqk', qb, kw).astype(jnp.float32) * scale
        pw = jax.nn.softmax(jnp.where(wmask, sw, NEG_INF), axis=-1)
        o_win = jnp.einsum('bghqk,bgkd->bghqd', pw.astype(vw.dtype), vw)
        return gb[..., 0:1] * o_cmp + gb[..., 1:2] * o_slc + gb[..., 2:3] * o_win

    out = lax.map(block, jnp.arange(S // Q_BLOCK))
    return out.transpose(1, 2, 3, 0, 4, 5).reshape(Bn, G, Hg, S, -1)


def pool_mixer(u, w_grp, scale):
    Bn, S, C = u.shape
    ug = u.reshape(Bn, S, C_GROUPS, C_GDIM).astype(jnp.float32)
    cs = jnp.pad(jnp.cumsum(ug, axis=1), ((0, 0), (1, 0), (0, 0), (0, 0)))
    t = jnp.arange(S)
    means = []
    for g, w in enumerate(C_WINDOWS):
        start = jnp.maximum(t + 1 - w, 0)
        cnt = (t + 1 - start).astype(jnp.float32)
        means.append((cs[:, 1:, g] - cs[:, start, g]) / cnt[None, :, None])
    pooled = (jnp.stack(means, axis=2) - ug).astype(u.dtype)
    y = jnp.einsum('bsgc,gcd->bsgd', pooled, w_grp)
    return y.reshape(Bn, S, C) * scale


def setup_inputs(seed: int = 0) -> dict:
    key = jax.random.key(seed)
    ks = jax.random.split(key, 20)
    L, D = DEPTH, D_MODEL
    nrm = lambda k, shape, s: jax.random.normal(k, shape, jnp.float32) * s
    return {
        'x': nrm(ks[0], (BATCH, SEQ, D), 1.0),
        'norm_g': 1.0 + nrm(ks[1], (L, D), 0.1),
        'w_in': nrm(ks[2], (L, D, N_IN), D ** -0.5),
        'a_q_g': 1.0 + nrm(ks[3], (L, A_DK), 0.1),
        'a_k_g': 1.0 + nrm(ks[4], (L, A_DK), 0.1),
        'a_lam': nrm(ks[5], (L, 4, A_DK), 0.1),
        'a_subln_g': 1.0 + nrm(ks[6], (L, A_DV), 0.1),
        'b_q_g': 1.0 + nrm(ks[7], (L, B_DK), 0.1),
        'b_k_g': 1.0 + nrm(ks[8], (L, N_NSA_BRANCH, B_DK), 0.1),
        'b_cmp_pos': nrm(ks[9], (L, 2, CMP_LEN, B_DK), 0.1),
        'b_phi_w1': nrm(ks[10], (L, 2, CMP_LEN * B_DK, PHI_HIDDEN), (CMP_LEN * B_DK) ** -0.5),
        'b_phi_w2': nrm(ks[11], (L, 2, PHI_HIDDEN, B_DK), PHI_HIDDEN ** -0.5),
        'c_w': nrm(ks[12], (L, C_GROUPS, C_GDIM, C_GDIM), C_GDIM ** -0.5),
        'c_scale': 1.0 + nrm(ks[13], (L, C_WIDTH), 0.1),
        'w_branch': nrm(ks[14], (L, N_BRANCH, BRANCH_WIDTH, D), BRANCH_WIDTH ** -0.5),
        'w_out': nrm(ks[15], (L, D, D), D ** -0.5),
    }


def reference(x, norm_g, w_in, a_q_g, a_k_g, a_lam, a_subln_g, b_q_g, b_k_g, b_cmp_pos,
              b_phi_w1, b_phi_w2, c_w, c_scale, w_branch, w_out):
    Bn, S, D = x.shape
    split_at = [int(v) for v in np.cumsum(SPLIT_SIZES)[:-1]]
    for l in range(DEPTH):
        h = rms_norm(x, norm_g[l])
        z = h @ w_in[l]
        aq, ak, av, ag, bq, bkv, bbg, bg, cu, cg, mg = jnp.split(z, split_at, axis=-1)

        qa = rms_norm(aq.reshape(Bn, S, A_HEADS, 2, A_DK), a_q_g[l]).transpose(0, 2, 3, 1, 4)
        ka = rms_norm(ak.reshape(Bn, S, A_HEADS, 2, A_DK), a_k_g[l]).transpose(0, 2, 3, 1, 4)
        va = av.reshape(Bn, S, A_HEADS, A_DV).transpose(0, 2, 1, 3)
        lam_init = 0.8 - 0.6 * math.exp(-0.3 * l)
        lp = a_lam[l].astype(jnp.float32)
        lam = jnp.exp(jnp.sum(lp[0] * lp[1])) - jnp.exp(jnp.sum(lp[2] * lp[3])) + lam_init
        oa = diff_attention(qa, ka, va, lam).transpose(0, 2, 1, 3)
        oa = (rms_norm(oa, a_subln_g[l]) * (1.0 - lam_init)).reshape(Bn, S, BRANCH_WIDTH)
        ya = (oa * jax.nn.silu(ag)) @ w_branch[l, 0]

        qb = rms_norm(bq.reshape(Bn, S, B_GROUPS, B_HPG, B_DK), b_q_g[l]).transpose(0, 2, 3, 1, 4)
        kv = bkv.reshape(Bn, S, N_NSA_BRANCH, 2, B_GROUPS, B_DK).transpose(2, 3, 0, 4, 1, 5)
        gates = jax.nn.sigmoid(bbg.reshape(Bn, S, B_GROUPS, B_HPG, N_NSA_BRANCH)).transpose(0, 2, 3, 1, 4)
        k_cmp = rms_norm(compress_blocks(kv[0, 0], b_cmp_pos[l, 0], b_phi_w1[l, 0], b_phi_w2[l, 0]), b_k_g[l, 0])
        v_cmp = compress_blocks(kv[0, 1], b_cmp_pos[l, 1], b_phi_w1[l, 1], b_phi_w2[l, 1])
        ns = S // SLC_LEN
        k_slc = rms_norm(kv[1, 0], b_k_g[l, 1]).reshape(Bn, B_GROUPS, ns, SLC_LEN, B_DK)
        v_slc = kv[1, 1].reshape(Bn, B_GROUPS, ns, SLC_LEN, B_DV)
        pad = ((0, 0), (0, 0), (WIN, 0), (0, 0))
        k_win = jnp.pad(rms_norm(kv[2, 0], b_k_g[l, 2]), pad)
        v_win = jnp.pad(kv[2, 1], pad)
        ob = nsa_attention(qb, k_cmp, v_cmp, k_slc, v_slc, k_win, v_win, gates)
        ob = ob.transpose(0, 3, 1, 2, 4).reshape(Bn, S, BRANCH_WIDTH)
        yb = (ob * jax.nn.silu(bg)) @ w_branch[l, 1]

        oc = pool_mixer(cu, c_w[l], c_scale[l])
        yc = (oc * jax.nn.silu(cg)) @ w_branch[l, 2]

        g = jax.nn.sigmoid(mg.reshape(Bn, S, N_BRANCH, D))
        merged = g[:, :, 0] * ya + g[:, :, 1] * yb + g[:, :, 2] * yc
        x = x + merged @ w_out[l]
    return x
```

```cpp
#include <hip/hip_runtime.h>
#include <hip/hip_cooperative_groups.h>
#include <stdint.h>
#include <stdio.h>
namespace cg = cooperative_groups;

#ifndef MK_ONE_LAUNCH
#define MK_ONE_LAUNCH 1
#endif

typedef unsigned short bf16_t;
typedef __attribute__((ext_vector_type(8))) short bf16x8;
typedef __attribute__((ext_vector_type(4))) short s16x4;
typedef __attribute__((ext_vector_type(16))) float f32x16;
typedef __attribute__((ext_vector_type(2))) __bf16 bf2_t;
typedef __attribute__((ext_vector_type(2))) float f2_t;
typedef __attribute__((ext_vector_type(4))) unsigned u32x4;

#define DI __device__ __forceinline__
#define MFMA32(a, b, c) __builtin_amdgcn_mfma_f32_32x32x16_bf16((a), (b), (c), 0, 0, 0)

constexpr int T_TOK = 16384, SEQ = 8192, DM = 1024, NIN = 7960;
constexpr float EPS = 1e-6f;
constexpr float QSCALE = 0.125f * 1.4426950408889634f;

constexpr size_t SZ_WIN_L = (size_t)8064 * 1024 * 2;
constexpr size_t SZ_WB_L = (size_t)3 * 1024 * 512 * 2;
constexpr size_t SZ_WO_L = (size_t)1024 * 1024 * 2;
constexpr size_t SZ_W1_L = (size_t)2 * 256 * 2048 * 2;
constexpr size_t SZ_W2_L = (size_t)2 * 64 * 256 * 2;
constexpr size_t SZ_CW_L = (size_t)4 * 128 * 128 * 2;
constexpr size_t SZ_512 = (size_t)T_TOK * 512 * 2;
constexpr size_t SZ_KS = (size_t)4 * SEQ * 64 * 2;
constexpr size_t OFF_WIN = 0;
constexpr size_t OFF_WB = OFF_WIN + 2 * SZ_WIN_L;
constexpr size_t OFF_WO = OFF_WB + 2 * SZ_WB_L;
constexpr size_t OFF_W1 = OFF_WO + 2 * SZ_WO_L;
constexpr size_t OFF_W2 = OFF_W1 + 2 * SZ_W1_L;
constexpr size_t OFF_CW = OFF_W2 + 2 * SZ_W2_L;
constexpr size_t OFF_B1 = OFF_CW + 2 * SZ_CW_L;
constexpr size_t OFF_H = OFF_B1 + 4096;
constexpr size_t OFF_QA = OFF_H + (size_t)T_TOK * 1024 * 2;
constexpr size_t OFF_KA = OFF_QA + SZ_512;
constexpr size_t OFF_VAT = OFF_KA + SZ_512;
constexpr size_t OFF_GA = OFF_VAT + SZ_512;
constexpr size_t OFF_QB = OFF_GA + SZ_512;
constexpr size_t OFF_CKV = OFF_QB + SZ_512;
constexpr size_t OFF_KS = OFF_CKV + 2 * SZ_KS;
constexpr size_t OFF_VST = OFF_KS + SZ_KS;
constexpr size_t OFF_KW = OFF_VST + SZ_KS;
constexpr size_t OFF_VWT = OFF_KW + SZ_KS;
constexpr size_t OFF_GB = OFF_VWT + SZ_KS;
constexpr size_t OFF_BGT = OFF_GB + SZ_512;
constexpr size_t OFF_CU = OFF_BGT + (size_t)T_TOK * 32 * 2;
constexpr size_t OFF_GC = OFF_CU + SZ_512;
constexpr size_t OFF_KC = OFF_GC + SZ_512;
constexpr size_t OFF_VCT = OFF_KC + (size_t)4 * 512 * 64 * 2;
constexpr size_t WS_END = OFF_VCT + (size_t)4 * 512 * 64 * 2;
constexpr size_t OFF_BAR = WS_END;
constexpr size_t WS_TOTAL = OFF_BAR + 16384;
constexpr size_t OFF_MERGED = OFF_QA;

constexpr int SMEM_BYTES = 75776;

struct Params {
  const float* x; const float* norm_g; const float* w_in; const float* a_q_g; const float* a_k_g; const float* a_lam;
  const float* a_subln_g; const float* b_q_g; const float* b_k_g; const float* b_cmp_pos; const float* b_phi_w1;
  const float* b_phi_w2; const float* c_w; const float* c_scale; const float* w_branch; const float* w_out;
  float* out; char* ws;
};

DI int tidx() { int t = (int)__builtin_amdgcn_workitem_id_x(); asm volatile("" : "+v"(t)); return t; }
DI unsigned pk2(float a, float b) { f2_t v = {a, b}; return __builtin_bit_cast(unsigned, __builtin_convertvector(v, bf2_t)); }
DI bf16_t f2bf(float a) { return (bf16_t)(pk2(a, 0.f) & 0xffffu); }
DI float bf2f(bf16_t b) { return __uint_as_float(((unsigned)b) << 16); }
DI float bflo(unsigned u) { return __uint_as_float(u << 16); }
DI float bfhi(unsigned u) { return __uint_as_float(u & 0xffff0000u); }
DI int crow(int i, int hh) { return (i & 3) + 8 * (i >> 2) + 4 * hh; }
DI float fast_exp2(float x) { return __builtin_amdgcn_exp2f(x); }
DI float sigmoidf_(float v) { return __builtin_amdgcn_rcpf(1.f + __expf(-v)); }
DI float siluf_(float v) { return v * __builtin_amdgcn_rcpf(1.f + __expf(-v)); }
DI f32x16 zero16() { f32x16 z; _Pragma("unroll") for (int i = 0; i < 16; ++i) z[i] = 0.f; return z; }
DI bf16x8 pack8(const f32x16& x, int s) {
  u32x4 p;
  p[0] = pk2(x[8 * s + 0], x[8 * s + 1]); p[1] = pk2(x[8 * s + 2], x[8 * s + 3]);
  p[2] = pk2(x[8 * s + 4], x[8 * s + 5]); p[3] = pk2(x[8 * s + 6], x[8 * s + 7]);
  return __builtin_bit_cast(bf16x8, p);
}
DI bf16x8 ld_vfrag(const bf16_t* p) {
  s16x4 lo = *(const s16x4*)p, hi = *(const s16x4*)(p + 8);
  return __builtin_shufflevector(lo, hi, 0, 1, 2, 3, 4, 5, 6, 7);
}

DI int win_src_col(int c, int& nvalid) {
  nvalid = 64;
  if (c < 40) return c * 64;
  if (c < 52) return 2560 + (c - 40) * 64;
  if (c < 60) return 3352 + (c - 52) * 64;
  if (c < 68) return 3864 + (c - 60) * 64;
  if (c < 76) return 4376 + (c - 68) * 64;
  if (c == 76) { nvalid = 24; return 3328; }
  if (c == 77) { nvalid = 0; return 0; }
  return 4888 + (c - 78) * 64;
}

template <int KT>
DI void tconv(const float* src, int ld, int nvalid, bf16_t* dst, int ldd, float* sm) {
  const int tid = tidx();
  __syncthreads();
  const int n = tid & 63, kb = tid >> 6;
  float v[KT / 4];
#pragma unroll
  for (int i = 0; i < KT / 4; ++i) v[i] = (n < nvalid) ? src[(size_t)(i * 4 + kb) * ld + n] : 0.f;
#pragma unroll
  for (int i = 0; i < KT / 4; ++i) sm[(i * 4 + kb) * 65 + n] = v[i];
  __syncthreads();
  const int nn = tid >> 2, kq = (tid & 3) * (KT / 4);
  u32x4* d = (u32x4*)(dst + (size_t)nn * ldd + kq);
#pragma unroll
  for (int q = 0; q < KT / 32; ++q) {
    u32x4 o;
#pragma unroll
    for (int i = 0; i < 4; ++i) o[i] = pk2(sm[(kq + 8 * q + 2 * i) * 65 + nn], sm[(kq + 8 * q + 2 * i + 1) * 65 + nn]);
    d[q] = o;
  }
}

constexpr int PREP_WIN = 126 * 4, PREP_WB = 96, PREP_WO = 64, PREP_W1 = 64, PREP_W2 = 2, PREP_CW = 8, PREP_B1 = 32;
constexpr int PREP_L = PREP_WIN + PREP_WB + PREP_WO + PREP_W1 + PREP_W2 + PREP_CW + PREP_B1;

DI void prep_tile(const Params& p, int idx, char* smem) {
  float* sm = (float*)smem;
  const int l = idx / PREP_L;
  int t = idx % PREP_L;
  char* ws = p.ws;
  if (t < PREP_WIN) {
    int c = t >> 2, kp = t & 3, nv; int sc = win_src_col(c, nv);
    tconv<256>(p.w_in + (size_t)l * DM * NIN + (size_t)kp * 256 * NIN + sc, NIN, nv,
               (bf16_t*)(ws + OFF_WIN + l * SZ_WIN_L) + (size_t)c * 64 * 1024 + kp * 256, 1024, sm);
    return;
  }
  t -= PREP_WIN;
  if (t < PREP_WB) {
    int br = t / 32, rem = t % 32, nc = rem >> 1, kp = rem & 1;
    tconv<256>(p.w_branch + ((size_t)(l * 3 + br) * 512 + kp * 256) * 1024 + nc * 64, 1024, 64,
               (bf16_t*)(ws + OFF_WB + l * SZ_WB_L) + ((size_t)br * 1024 + nc * 64) * 512 + kp * 256, 512, sm);
    return;
  }
  t -= PREP_WB;
  if (t < PREP_WO) {
    int nc = t >> 2, kp = t & 3;
    tconv<256>(p.w_out + ((size_t)l * 1024 + kp * 256) * 1024 + nc * 64, 1024, 64,
               (bf16_t*)(ws + OFF_WO + l * SZ_WO_L) + (size_t)nc * 64 * 1024 + kp * 256, 1024, sm);
    return;
  }
  t -= PREP_WO;
  if (t < PREP_W1) {
    int j = t >> 5, rem = t & 31, nc = rem >> 3, kp = rem & 7;
    tconv<256>(p.b_phi_w1 + ((size_t)(l * 2 + j) * 2048 + kp * 256) * 256 + nc * 64, 256, 64,
               (bf16_t*)(ws + OFF_W1 + l * SZ_W1_L) + ((size_t)j * 256 + nc * 64) * 2048 + kp * 256, 2048, sm);
    return;
  }
  t -= PREP_W1;
  if (t < PREP_W2) {
    int j = t;
    tconv<256>(p.b_phi_w2 + (size_t)(l * 2 + j) * 256 * 64, 64, 64,
               (bf16_t*)(ws + OFF_W2 + l * SZ_W2_L) + (size_t)j * 64 * 256, 256, sm);
    return;
  }
  t -= PREP_W2;
  if (t < PREP_CW) {
    int g = t >> 1, nc = t & 1;
    tconv<128>(p.c_w + ((size_t)(l * 4 + g) * 128) * 128 + nc * 64, 128, 64,
               (bf16_t*)(ws + OFF_CW + l * SZ_CW_L) + ((size_t)g * 128 + nc * 64) * 128, 128, sm);
    return;
  }
  t -= PREP_CW;
  {
    const int j = t >> 4, n0 = (t & 15) * 16;
    const int tid = tidx(), n = n0 + (tid & 15), kg = tid >> 4;
    const float* pos = p.b_cmp_pos + (size_t)(l * 2 + j) * 2048;
    const float* w1 = p.b_phi_w1 + (size_t)(l * 2 + j) * 2048 * 256;
    float a0 = 0.f, a1 = 0.f, a2 = 0.f, a3 = 0.f;
#pragma unroll 4
    for (int i = 0; i < 128; i += 4) {
      const int k = kg + 16 * i;
      a0 += pos[k] * w1[(size_t)k * 256 + n];
      a1 += pos[k + 16] * w1[(size_t)(k + 16) * 256 + n];
      a2 += pos[k + 32] * w1[(size_t)(k + 32) * 256 + n];
      a3 += pos[k + 48] * w1[(size_t)(k + 48) * 256 + n];
    }
    __syncthreads();
    sm[tid] = (a0 + a1) + (a2 + a3);
    __syncthreads();
    if (tid < 16) {
      float s = 0.f;
#pragma unroll
      for (int g = 0; g < 16; ++g) s += sm[g * 16 + tid];
      ((float*)(ws + OFF_B1))[(l * 2 + j) * 256 + n0 + tid] = s;
    }
  }
}

DI void norm_tile(const Params& p, int l, int tile) {
  const float* xin = l == 0 ? p.x : p.out;
  const int lane = tidx() & 63, wave = tidx() >> 6;
  bf16_t* H = (bf16_t*)(p.ws + OFF_H);
  const float* g = p.norm_g + l * DM;
  const int row0 = tile * 16 + wave * 4;
  float4 v[4][4];
#pragma unroll
  for (int rr = 0; rr < 4; ++rr) {
    const float4* xr = (const float4*)(xin + (size_t)(row0 + rr) * DM);
#pragma unroll
    for (int i = 0; i < 4; ++i) v[rr][i] = xr[i * 64 + lane];
  }
  float4 gg[4];
#pragma unroll
  for (int i = 0; i < 4; ++i) gg[i] = ((const float4*)g)[i * 64 + lane];
#pragma unroll
  for (int rr = 0; rr < 4; ++rr) {
    float ss = 0.f;
#pragma unroll
    for (int i = 0; i < 4; ++i) ss += v[rr][i].x * v[rr][i].x + v[rr][i].y * v[rr][i].y + v[rr][i].z * v[rr][i].z + v[rr][i].w * v[rr][i].w;
#pragma unroll
    for (int o = 32; o >= 1; o >>= 1) ss += __shfl_xor(ss, o);
    const float rinv = rsqrtf(ss * (1.f / DM) + EPS);
#pragma unroll
    for (int i = 0; i < 4; ++i) {
      uint2 o; o.x = pk2(v[rr][i].x * rinv * gg[i].x, v[rr][i].y * rinv * gg[i].y);
      o.y = pk2(v[rr][i].z * rinv * gg[i].z, v[rr][i].w * rinv * gg[i].w);
      *(uint2*)(H + (size_t)(row0 + rr) * DM + (i * 64 + lane) * 4) = o;
    }
  }
}

#define RAW_BARRIER() do { asm volatile("s_waitcnt lgkmcnt(0)" ::: "memory"); __builtin_amdgcn_s_barrier(); } while (0)
DI void glds16(const bf16_t* g, char* l) {
  unsigned keep;
  const unsigned dst = __builtin_amdgcn_readfirstlane((unsigned)(size_t)l);
  asm volatile("s_mov_b32 %0, m0\n\ts_mov_b32 m0, %2\n\ts_nop 0\n\tglobal_load_lds_dwordx4 %1, off\n\ts_mov_b32 m0, %0"
               : "=&s"(keep) : "v"(g), "s"(dst) : "memory");
}
template <int MT>
DI void gemm_slice(char* __restrict__ dst, const char* __restrict__ src, bool issue, const bf16_t* const (&gA)[MT],
                   const bf16_t* const (&gB)[2], int ko, int wbA, int wbB, int offA, int offB, int hh, int sw,
                   f32x16 (&acc)[MT][2]) {
  bf16x8 fa[2][MT], fb[2][2];
#pragma unroll
  for (int s = 0; s < 2; ++s) {
    const int pc = ((2 * s + hh) ^ sw) * 16;
    fb[s][0] = *(const bf16x8*)(src + offB + pc);
    fb[s][1] = *(const bf16x8*)(src + offB + 2048 + pc);
#pragma unroll
    for (int mt = 0; mt < MT; ++mt) fa[s][mt] = *(const bf16x8*)(src + offA + mt * 2048 + pc);
  }
  __builtin_amdgcn_sched_barrier(0);
  if (issue) {
#pragma unroll
    for (int i = 0; i < MT; ++i) glds16(gA[i] + ko, dst + wbA + i * 1024);
#pragma unroll
    for (int i = 0; i < 2; ++i) glds16(gB[i] + ko, dst + wbB + i * 1024);
  }
  __builtin_amdgcn_sched_barrier(0);
#pragma unroll
  for (int s = 0; s < 2; ++s)
#pragma unroll
    for (int mt = 0; mt < MT; ++mt) {
      acc[mt][0] = MFMA32(fa[s][mt], fb[s][0], acc[mt][0]);
      acc[mt][1] = MFMA32(fa[s][mt], fb[s][1], acc[mt][1]);
    }
}

template <int NST, int MT>
DI void gemm_nt(const bf16_t* __restrict__ A, int lda, int rowmax, const bf16_t* __restrict__ B, int ldb, int K,
                f32x16 (&acc)[MT][2], char* smem) {
  constexpr int ABYTES = MT * 4096, STAGE = ABYTES + 8192;
  const int tid = tidx(), lane = tid & 63, wave = tid >> 6, r = lane & 31, hh = lane >> 5, wm = wave >> 1, wn = wave & 1;
  const bf16_t* gA[MT]; const bf16_t* gB[2];
#pragma unroll
  for (int i = 0; i < MT; ++i) {
    const int rl = (wave * MT + i) * 16 + (lane >> 2);
    const int c = (lane & 3) ^ ((rl >> 2) & 3);
    const int ar = rl < rowmax ? rl : rowmax;
    gA[i] = A + (size_t)ar * lda + c * 8;
  }
#pragma unroll
  for (int i = 0; i < 2; ++i) {
    const int rl = (wave * 2 + i) * 16 + (lane >> 2);
    const int c = (lane & 3) ^ ((rl >> 2) & 3);
    gB[i] = B + (size_t)rl * ldb + c * 8;
  }
  const int wv = __builtin_amdgcn_readfirstlane(wave);
  const int wbA = wv * (MT * 1024), wbB = ABYTES + wv * 2048;
  const int nk = K >> 5;
  const int sw = (r >> 2) & 3;
  const int offA = (wm * 32 * MT + r) * 64, offB = ABYTES + (wn * 64 + r) * 64;
  __syncthreads();
#pragma unroll
  for (int s = 0; s < NST - 1; ++s)
    if (s < nk) {
      char* sb = smem + s * STAGE;
#pragma unroll
      for (int i = 0; i < MT; ++i) glds16(gA[i] + s * 32, sb + wbA + i * 1024);
#pragma unroll
      for (int i = 0; i < 2; ++i) glds16(gB[i] + s * 32, sb + wbB + i * 1024);
    }
  constexpr int PER = MT + 2;
  for (int kt0 = 0; kt0 < nk; kt0 += NST) {
#pragma unroll
    for (int u = 0; u < NST; ++u) {
      const int kt = kt0 + u;
      if (kt < nk) {
        const int rem = nk - 1 - kt;
        if (NST >= 4 && rem >= 2) { if (PER == 4) asm volatile("s_waitcnt vmcnt(8)" ::: "memory"); else asm volatile("s_waitcnt vmcnt(12)" ::: "memory"); }
        else if (NST >= 3 && rem >= 1) { if (PER == 4) asm volatile("s_waitcnt vmcnt(4)" ::: "memory"); else asm volatile("s_waitcnt vmcnt(6)" ::: "memory"); }
        else asm volatile("s_waitcnt vmcnt(0)" ::: "memory");
        RAW_BARRIER();
        gemm_slice<MT>(smem + ((u + NST - 1) % NST) * STAGE, smem + u * STAGE, kt + NST - 1 < nk, gA, gB,
                       (kt + NST - 1) * 32, wbA, wbB, offA, offB, hh, sw, acc);
      }
    }
  }
}
template <int NST>
DI void gemm128_nt(const bf16_t* __restrict__ A, int lda, int rowmax, const bf16_t* __restrict__ B, int ldb, int K,
                   f32x16 (&acc)[2][2], char* smem) {
  gemm_nt<NST, 2>(A, lda, rowmax, B, ldb, K, acc, smem);
}

DI void store_row32(bf16_t* dst, const float (&v)[32]) {
#pragma unroll
  for (int q = 0; q < 4; ++q) {
    u32x4 u; u[0] = pk2(v[8 * q], v[8 * q + 1]); u[1] = pk2(v[8 * q + 2], v[8 * q + 3]);
    u[2] = pk2(v[8 * q + 4], v[8 * q + 5]); u[3] = pk2(v[8 * q + 6], v[8 * q + 7]);
    ((u32x4*)dst)[q] = u;
  }
}
DI void store_col32(bf16_t* dst, size_t stride, const float (&v)[32]) {
#pragma unroll
  for (int i = 0; i < 32; ++i) dst[(size_t)i * stride] = f2bf(v[i]);
}
DI void norm32(float (&v)[32], const float* gain, float scale) {
  float ss = 0.f;
#pragma unroll
  for (int i = 0; i < 32; ++i) ss += v[i] * v[i];
  ss += __shfl_xor(ss, 32);
  float rinv = rsqrtf(ss * (1.f / 64.f) + EPS) * scale;
#pragma unroll
  for (int i = 0; i < 32; ++i) v[i] = v[i] * rinv * gain[i];
}

DI void inproj_tile(const Params& p, int l, int rt, int ct, char* smem) {
  const int tid = tidx(), lane = tid & 63, wave = tid >> 6, r = lane & 31, hh = lane >> 5, wm = wave >> 1, wn = wave & 1;
  char* ws = p.ws;
  f32x16 acc[4][2];
#pragma unroll
  for (int a = 0; a < 4; ++a) for (int b = 0; b < 2; ++b) acc[a][b] = zero16();
  gemm_nt<3, 4>((const bf16_t*)(ws + OFF_H) + (size_t)rt * 256 * 1024, 1024, 255,
                (const bf16_t*)(ws + OFF_WIN + l * SZ_WIN_L) + (size_t)ct * 128 * 1024, 1024, 1024, acc, smem);
  __syncthreads();
  float* ep = (float*)smem + wave * (32 * 68);
  const int c = ct * 2 + wn;
#pragma unroll
  for (int mt = 0; mt < 4; ++mt) {
#pragma unroll
    for (int nt = 0; nt < 2; ++nt)
#pragma unroll
      for (int i = 0; i < 16; ++i) ep[crow(i, hh) * 68 + nt * 32 + r] = acc[mt][nt][i];
    __builtin_amdgcn_fence(__ATOMIC_RELEASE, "wavefront"); __builtin_amdgcn_wave_barrier(); __builtin_amdgcn_fence(__ATOMIC_ACQUIRE, "wavefront");
    float v[32];
#pragma unroll
    for (int q = 0; q < 8; ++q) {
      float4 f = *(const float4*)(ep + r * 68 + hh * 32 + q * 4);
      v[4 * q] = f.x; v[4 * q + 1] = f.y; v[4 * q + 2] = f.z; v[4 * q + 3] = f.w;
    }
    const int t = rt * 256 + wm * 128 + mt * 32 + r;
    const int b = t >> 13, s = t & (SEQ - 1);
    const int co = hh * 32;
    if (c < 8) {
      norm32(v, p.a_q_g + l * 64 + co, QSCALE);
      store_row32((bf16_t*)(ws + OFF_QA) + (size_t)t * 512 + c * 64 + co, v);
    } else if (c < 16) {
      norm32(v, p.a_k_g + l * 64 + co, 1.f);
      store_row32((bf16_t*)(ws + OFF_KA) + (size_t)t * 512 + (c - 8) * 64 + co, v);
    } else if (c < 24) {
      store_col32((bf16_t*)(ws + OFF_VAT) + ((size_t)b * 512 + (c - 16) * 64 + co) * SEQ + s, SEQ, v);
    } else if (c < 32) {
#pragma unroll
      for (int i = 0; i < 32; ++i) v[i] = siluf_(v[i]);
      store_row32((bf16_t*)(ws + OFF_GA) + (size_t)t * 512 + (c - 24) * 64 + co, v);
    } else if (c < 40) {
      norm32(v, p.b_q_g + l * 64 + co, QSCALE);
      store_row32((bf16_t*)(ws + OFF_QB) + (size_t)t * 512 + (c - 32) * 64 + co, v);
    } else if (c < 52) {
      const int sub = c - 40, br = sub >> 2, kv = (sub >> 1) & 1, g = sub & 1, bg = b * 2 + g;
      if (br == 0) {
        store_row32((bf16_t*)(ws + OFF_CKV) + ((size_t)(kv * 4 + bg) * SEQ + s) * 64 + co, v);
      } else if (kv == 0) {
        norm32(v, p.b_k_g + (l * 3 + br) * 64 + co, 1.f);
        store_row32((bf16_t*)(ws + (br == 1 ? OFF_KS : OFF_KW)) + ((size_t)bg * SEQ + s) * 64 + co, v);
      } else {
        store_col32((bf16_t*)(ws + (br == 1 ? OFF_VST : OFF_VWT)) + ((size_t)bg * 64 + co) * SEQ + s, SEQ, v);
      }
    } else if (c < 60) {
#pragma unroll
      for (int i = 0; i < 32; ++i) v[i] = siluf_(v[i]);
      store_row32((bf16_t*)(ws + OFF_GB) + (size_t)t * 512 + (c - 52) * 64 + co, v);
    } else if (c < 68) {
      store_row32((bf16_t*)(ws + OFF_CU) + (size_t)t * 512 + (c - 60) * 64 + co, v);
    } else if (c < 76) {
#pragma unroll
      for (int i = 0; i < 32; ++i) v[i] = siluf_(v[i]);
      store_row32((bf16_t*)(ws + OFF_GC) + (size_t)t * 512 + (c - 68) * 64 + co, v);
    } else if (c == 76) {
      if (hh == 0) {
#pragma unroll
        for (int i = 0; i < 32; ++i) v[i] = sigmoidf_(v[i]);
        store_row32((bf16_t*)(ws + OFF_BGT) + (size_t)t * 32, v);
      }
    }
    __builtin_amdgcn_fence(__ATOMIC_RELEASE, "wavefront"); __builtin_amdgcn_wave_barrier(); __builtin_amdgcn_fence(__ATOMIC_ACQUIRE, "wavefront");
  }
}

DI void diff_tile(const Params& p, int l, int b, int h, int qt, float lam, float lam_init, char* smem) {
  bf16_t* K1s = (bf16_t*)smem; bf16_t* K2s = K1s + 64 * 72; bf16_t* VTs = K2s + 64 * 72;
  const int tid = tidx(), lane = tid & 63, wave = tid >> 6, r = lane & 31, hh = lane >> 5;
  const int lr = tid >> 3, cc = tid & 7;
  const int m = wave >> 1, wq = wave & 1;
  char* ws = p.ws;
  const int q0 = qt * 64, qlo = q0 + 32 * wq, q = qlo + r;
  const bf16_t* KA = (const bf16_t*)(ws + OFF_KA) + (size_t)b * SEQ * 512 + h * 128;
  const bf16_t* VAT = (const bf16_t*)(ws + OFF_VAT) + ((size_t)b * 512 + h * 128) * SEQ;
  const bf16_t* Ks = m ? K2s : K1s;
  bf16x8 qf[4];
  {
    const bf16_t* qrow = (const bf16_t*)(ws + OFF_QA) + (size_t)(b * SEQ + q) * 512 + h * 128 + m * 64;
#pragma unroll
    for (int s = 0; s < 4; ++s) qf[s] = *(const bf16x8*)(qrow + s * 16 + hh * 8);
  }
  f32x16 O[4];
#pragma unroll
  for (int i = 0; i < 4; ++i) O[i] = zero16();
  float lsum = 0.f;
  const int nkt = qt + 1;
  u32x4 rk1[2], rk2[2], rv[4];
  auto issue_loads = [&](int k0) {
#pragma unroll
    for (int i = 0; i < 2; ++i) {
      const bf16_t* src = KA + (size_t)(k0 + lr + 32 * i) * 512 + cc * 8;
      rk1[i] = *(const u32x4*)src;
      rk2[i] = *(const u32x4*)(src + 64);
    }
#pragma unroll
    for (int i = 0; i < 4; ++i) rv[i] = *(const u32x4*)(VAT + (size_t)(lr + 32 * i) * SEQ + k0 + cc * 8);
  };
  issue_loads(0);
  for (int kt = 0; kt < nkt; ++kt) {
    const int k0 = kt * 64;
    __syncthreads();
#pragma unroll
    for (int i = 0; i < 2; ++i) {
      int row = lr + 32 * i;
      *(u32x4*)(K1s + row * 72 + cc * 8) = rk1[i];
      *(u32x4*)(K2s + row * 72 + cc * 8) = rk2[i];
    }
#pragma unroll
    for (int i = 0; i < 4; ++i) {
      int row = lr + 32 * i;
      bf16_t* d = VTs + row * 72 + (cc >> 1) * 16 + (cc & 1) * 4;
      *(uint2*)d = make_uint2(rv[i][0], rv[i][1]); *(uint2*)(d + 8) = make_uint2(rv[i][2], rv[i][3]);
    }
    __syncthreads();
    if (kt + 1 < nkt) issue_loads(k0 + 64);
    __builtin_amdgcn_sched_barrier(0);
    if (k0 + 63 <= qlo) {
      f32x16 sa = zero16(), sb = zero16();
#pragma unroll
      for (int s = 0; s < 4; ++s) {
        bf16x8 a1 = *(const bf16x8*)(Ks + r * 72 + s * 16 + hh * 8);
        bf16x8 a2 = *(const bf16x8*)(Ks + (32 + r) * 72 + s * 16 + hh * 8);
        sa = MFMA32(a1, qf[s], sa);
        sb = MFMA32(a2, qf[s], sb);
      }
      float la = 0.f, lb = 0.f;
#pragma unroll
      for (int i = 0; i < 16; ++i) { float pa = fast_exp2(sa[i]); sa[i] = pa; la += pa; }
#pragma unroll
      for (int sp = 0; sp < 2; ++sp) {
        bf16x8 pfa = pack8(sa, sp);
#pragma unroll
        for (int dt = 0; dt < 4; ++dt) {
          bf16x8 va = *(const bf16x8*)(VTs + (32 * dt + r) * 72 + 16 * sp + 8 * hh);
          O[dt] = MFMA32(va, pfa, O[dt]);
          const int j = 2 * (sp * 4 + dt);
          float p0 = fast_exp2(sb[j]), p1 = fast_exp2(sb[j + 1]);
          sb[j] = p0; sb[j + 1] = p1; lb += p0 + p1;
        }
      }
      lsum += la + lb;
#pragma unroll
      for (int sp = 0; sp < 2; ++sp) {
        bf16x8 pfb = pack8(sb, sp);
#pragma unroll
        for (int dt = 0; dt < 4; ++dt) {
          bf16x8 vb = *(const bf16x8*)(VTs + (32 * dt + r) * 72 + 32 + 16 * sp + 8 * hh);
          O[dt] = MFMA32(vb, pfb, O[dt]);
        }
      }
    } else
#pragma unroll
    for (int ks = 0; ks < 2; ++ks) {
      const int kb = k0 + 32 * ks;
      if (kb <= qlo + 31) {
        f32x16 s1 = zero16();
#pragma unroll
        for (int s = 0; s < 4; ++s) {
          bf16x8 a1 = *(const bf16x8*)(Ks + (32 * ks + r) * 72 + s * 16 + hh * 8);
          s1 = MFMA32(a1, qf[s], s1);
        }
        if (kb + 31 > qlo) {
#pragma unroll
          for (int i = 0; i < 16; ++i) {
            float p1 = (kb + crow(i, hh) <= q) ? fast_exp2(s1[i]) : 0.f;
            s1[i] = p1; lsum += p1;
          }
        } else {
          float la = 0.f, lb = 0.f;
#pragma unroll
          for (int i = 0; i < 16; i += 2) {
            float p1 = fast_exp2(s1[i]), p2 = fast_exp2(s1[i + 1]);
            s1[i] = p1; s1[i + 1] = p2; la += p1; lb += p2;
          }
          lsum += la + lb;
        }
#pragma unroll
        for (int sp = 0; sp < 2; ++sp) {
          bf16x8 pf1 = pack8(s1, sp);
#pragma unroll
          for (int dt = 0; dt < 4; ++dt) {
            bf16x8 vf = *(const bf16x8*)(VTs + (32 * dt + r) * 72 + 32 * ks + 16 * sp + 8 * hh);
            O[dt] = MFMA32(vf, pf1, O[dt]);
          }
        }
      }
    }
  }
  lsum += __shfl_xor(lsum, 32);
  const float sc = m == 0 ? 1.f / lsum : lam / lsum;
  __syncthreads();
  float* ex = (float*)smem + wq * 4096 + lane;
  if (m == 1) {
#pragma unroll
    for (int dt = 0; dt < 4; ++dt)
#pragma unroll
      for (int i = 0; i < 16; ++i) ex[(dt * 16 + i) * 64] = O[dt][i] * sc;
  }
  __syncthreads();
  if (m == 0) {
    float ss = 0.f;
#pragma unroll
    for (int dt = 0; dt < 4; ++dt)
#pragma unroll
      for (int i = 0; i < 16; ++i) { float o = O[dt][i] * sc - ex[(dt * 16 + i) * 64]; O[dt][i] = o; ss += o * o; }
    ss += __shfl_xor(ss, 32);
    const float rinv = rsqrtf(ss * (1.f / 128.f) + EPS) * (1.f - lam_init);
    bf16_t* ga = (bf16_t*)(ws + OFF_GA) + (size_t)(b * SEQ + q) * 512 + h * 128;
    const float* sg = p.a_subln_g + l * 128;
#pragma unroll
    for (int dt = 0; dt < 4; ++dt)
#pragma unroll
      for (int ig = 0; ig < 4; ++ig) {
        const int dv = 32 * dt + 8 * ig + 4 * hh;
        uint2 gate = *(const uint2*)(ga + dv);
        float4 g4 = *(const float4*)(sg + dv);
        float y0 = O[dt][4 * ig + 0] * rinv * g4.x * bflo(gate.x);
        float y1 = O[dt][4 * ig + 1] * rinv * g4.y * bfhi(gate.x);
        float y2 = O[dt][4 * ig + 2] * rinv * g4.z * bflo(gate.y);
        float y3 = O[dt][4 * ig + 3] * rinv * g4.w * bfhi(gate.y);
        *(uint2*)(ga + dv) = make_uint2(pk2(y0, y1), pk2(y2, y3));
      }
  }
}

DI void compress_tile(const Params& p, int l, int idx, char* smem) {
  bf16_t* Hs = (bf16_t*)(smem + 36864);
  const int tid = tidx(), lane = tid & 63, wave = tid >> 6, r = lane & 31, hh = lane >> 5, wm = wave >> 1, wn = wave & 1;
  char* ws = p.ws;
  const int j = idx & 1, rt = (idx >> 1) & 3, bg = idx >> 3;
  const bf16_t* A = (const bf16_t*)(ws + OFF_CKV) + (size_t)(j * 4 + bg) * SEQ * 64 + (size_t)rt * 128 * 1024;
  const int rowmax = 510 - rt * 128;
  const float* bias = (const float*)(ws + OFF_B1) + (l * 2 + j) * 256;
  const bf16_t* W1 = (const bf16_t*)(ws + OFF_W1 + l * SZ_W1_L) + (size_t)j * 256 * 2048;
  const bf16_t* W2 = (const bf16_t*)(ws + OFF_W2 + l * SZ_W2_L) + (size_t)j * 64 * 256;
  f32x16 acc2[2]; acc2[0] = zero16(); acc2[1] = zero16();
  for (int half = 0; half < 2; ++half) {
    f32x16 acc[2][2];
#pragma unroll
    for (int a = 0; a < 2; ++a) for (int b = 0; b < 2; ++b) acc[a][b] = zero16();
    gemm128_nt<2>(A, 1024, rowmax < 127 ? rowmax : 127, W1 + (size_t)half * 128 * 2048, 2048, 2048, acc, smem);
#pragma unroll
    for (int mt = 0; mt < 2; ++mt)
#pragma unroll
      for (int nt = 0; nt < 2; ++nt) {
        const int col = wn * 64 + nt * 32 + r;
        const float bv = bias[half * 128 + col];
#pragma unroll
        for (int i = 0; i < 16; ++i) {
          const int row = wm * 64 + mt * 32 + crow(i, hh);
          Hs[row * 136 + col] = f2bf(siluf_(acc[mt][nt][i] + bv));
        }
      }
    __syncthreads();
#pragma unroll
    for (int s = 0; s < 8; ++s) {
      bf16x8 a = *(const bf16x8*)(Hs + (32 * wave + r) * 136 + 16 * s + 8 * hh);
#pragma unroll
      for (int nt = 0; nt < 2; ++nt) {
        bf16x8 bb = *(const bf16x8*)(W2 + (size_t)(32 * nt + r) * 256 + half * 128 + 16 * s + 8 * hh);
        acc2[nt] = MFMA32(a, bb, acc2[nt]);
      }
    }
    __syncthreads();
  }
  if (j == 0) {
    bf16_t* KC = (bf16_t*)(ws + OFF_KC) + (size_t)bg * 512 * 64;
    const float g0 = p.b_k_g[(l * 3 + 0) * 64 + r], g1 = p.b_k_g[(l * 3 + 0) * 64 + 32 + r];
#pragma unroll
    for (int i = 0; i < 16; ++i) {
      float ss = acc2[0][i] * acc2[0][i] + acc2[1][i] * acc2[1][i];
#pragma unroll
      for (int o = 16; o >= 1; o >>= 1) ss += __shfl_xor(ss, o);
      float rinv = rsqrtf(ss * (1.f / 64.f) + EPS);
      const int n = rt * 128 + 32 * wave + crow(i, hh);
      const bool valid = n <= 510;
      KC[(size_t)n * 64 + r] = valid ? f2bf(acc2[0][i] * rinv * g0) : (bf16_t)0;
      KC[(size_t)n * 64 + 32 + r] = valid ? f2bf(acc2[1][i] * rinv * g1) : (bf16_t)0;
    }
  } else {
    bf16_t* VCT = (bf16_t*)(ws + OFF_VCT) + (size_t)bg * 64 * 512;
#pragma unroll
    for (int nt = 0; nt < 2; ++nt)
#pragma unroll
      for (int ig = 0; ig < 4; ++ig) {
        const int n = rt * 128 + 32 * wave + 8 * ig + 4 * hh;
        float v0 = acc2[nt][4 * ig], v1 = acc2[nt][4 * ig + 1], v2 = acc2[nt][4 * ig + 2], v3 = acc2[nt][4 * ig + 3];
        if (n + 3 > 510) v3 = 0.f;
        *(uint2*)(VCT + (size_t)(32 * nt + r) * 512 + n) = make_uint2(pk2(v0, v1), pk2(v2, v3));
      }
  }
}

DI void pool_tile(const Params& p, int l, int rt, int grp, char* smem) {
  bf16_t* Us = (bf16_t*)smem; bf16_t* Ps = Us + 144 * 136;
  const int tid = tidx(), lane = tid & 63, wave = tid >> 6, r = lane & 31, hh = lane >> 5;
  char* ws = p.ws;
  const int t0 = rt * 128, sq0 = t0 & (SEQ - 1);
  const bf16_t* CU = (const bf16_t*)(ws + OFF_CU);
  __syncthreads();
#pragma unroll
  for (int i = 0; i < 9; ++i) {
    int id = tid + 256 * i, row = id >> 4, c16 = id & 15;
    u32x4 v = {0u, 0u, 0u, 0u};
    if (sq0 - 16 + row >= 0) v = *(const u32x4*)(CU + (size_t)(t0 - 16 + row) * 512 + grp * 128 + c16 * 8);
    *(u32x4*)(Us + row * 136 + c16 * 8) = v;
  }
  __syncthreads();
  {
    const int w = 2 << grp, c = tid & 127, rh = tid >> 7;
    float sum = 0.f;
    for (int i = 0; i < w; ++i) sum += bf2f(Us[(rh * 64 + 16 - i) * 136 + c]);
    for (int lrow = rh * 64; lrow < rh * 64 + 64; ++lrow) {
      float cur = bf2f(Us[(lrow + 16) * 136 + c]);
      if (lrow != rh * 64) sum += cur - bf2f(Us[(lrow + 16 - w) * 136 + c]);
      int cnt = sq0 + lrow + 1; cnt = cnt < w ? cnt : w;
      Ps[lrow * 136 + c] = f2bf(sum / (float)cnt - cur);
    }
  }
  __syncthreads();
  f32x16 acc[4];
#pragma unroll
  for (int i = 0; i < 4; ++i) acc[i] = zero16();
  const bf16_t* CW = (const bf16_t*)(ws + OFF_CW + l * SZ_CW_L) + (size_t)grp * 128 * 128;
#pragma unroll
  for (int s = 0; s < 8; ++s) {
    bf16x8 a = *(const bf16x8*)(Ps + (32 * wave + r) * 136 + 16 * s + 8 * hh);
#pragma unroll
    for (int nt = 0; nt < 4; ++nt) {
      bf16x8 bb = *(const bf16x8*)(CW + (size_t)(32 * nt + r) * 128 + 16 * s + 8 * hh);
      acc[nt] = MFMA32(a, bb, acc[nt]);
    }
  }
  bf16_t* GC = (bf16_t*)(ws + OFF_GC);
#pragma unroll
  for (int nt = 0; nt < 4; ++nt) {
    const int col = grp * 128 + 32 * nt + r;
    const float sc = p.c_scale[l * 512 + col];
#pragma unroll
    for (int i = 0; i < 16; ++i) {
      const size_t idx = (size_t)(t0 + 32 * wave + crow(i, hh)) * 512 + col;
      GC[idx] = f2bf(acc[nt][i] * sc * bf2f(GC[idx]));
    }
  }
}

DI void nsa_load_kv(bf16_t* Ks, bf16_t* VTs, const bf16_t* ksrc  ,
                    const bf16_t* vsrc  , size_t ldv, bool loadv) {
  const int tid = tidx(), lr = tid >> 3, cc = tid & 7;
#pragma unroll
  for (int i = 0; i < 2; ++i) {
    int row = lr + 32 * i;
    *(u32x4*)(Ks + row * 72 + cc * 8) = *(const u32x4*)(ksrc + (size_t)row * 64 + cc * 8);
    if (loadv) {
      u32x4 v = *(const u32x4*)(vsrc + (size_t)row * ldv + cc * 8);
      bf16_t* d = VTs + row * 72 + (cc >> 1) * 16 + (cc & 1) * 4;
      *(uint2*)d = make_uint2(v[0], v[1]); *(uint2*)(d + 8) = make_uint2(v[2], v[3]);
    }
  }
}
DI void nsa_load_kv2(bf16_t* Ks, bf16_t* VTs, const bf16_t* k0, const bf16_t* v0, const bf16_t* k1, const bf16_t* v1, size_t ldv) {
  const int tid = tidx(), lr = tid >> 3, cc = tid & 7;
  u32x4 rk[4], rv[4];
#pragma unroll
  for (int i = 0; i < 2; ++i) {
    const int row = lr + 32 * i;
    rk[i] = *(const u32x4*)(k0 + (size_t)row * 64 + cc * 8);
    rk[2 + i] = *(const u32x4*)(k1 + (size_t)row * 64 + cc * 8);
    rv[i] = *(const u32x4*)(v0 + (size_t)row * ldv + cc * 8);
    rv[2 + i] = *(const u32x4*)(v1 + (size_t)row * ldv + cc * 8);
  }
  __builtin_amdgcn_sched_barrier(0);
#pragma unroll
  for (int i = 0; i < 2; ++i) {
    const int row = lr + 32 * i;
    *(u32x4*)(Ks + row * 72 + cc * 8) = rk[i];
    *(u32x4*)(Ks + 64 * 72 + row * 72 + cc * 8) = rk[2 + i];
    bf16_t* d0 = VTs + row * 72 + (cc >> 1) * 16 + (cc & 1) * 4;
    *(uint2*)d0 = make_uint2(rv[i][0], rv[i][1]); *(uint2*)(d0 + 8) = make_uint2(rv[i][2], rv[i][3]);
    bf16_t* d1 = d0 + 64 * 72;
    *(uint2*)d1 = make_uint2(rv[2 + i][0], rv[2 + i][1]); *(uint2*)(d1 + 8) = make_uint2(rv[2 + i][2], rv[2 + i][3]);
  }
}
DI f32x16 nsa_scores(const bf16_t* Ks, int ks, int r, int hh, const bf16x8 (&qf)[4], float init = 0.f) {
  f32x16 s;
#pragma unroll
  for (int i = 0; i < 16; ++i) s[i] = init;
#pragma unroll
  for (int k = 0; k < 4; ++k) {
    bf16x8 a = *(const bf16x8*)(Ks + (32 * ks + r) * 72 + k * 16 + hh * 8);
    s = MFMA32(a, qf[k], s);
  }
  return s;
}
DI void nsa_pv(const bf16_t* VTs, int ks, int r, int hh, const f32x16& pr, f32x16 (&o)[2]) {
#pragma unroll
  for (int sp = 0; sp < 2; ++sp) {
    bf16x8 pf = pack8(pr, sp);
#pragma unroll
    for (int dt = 0; dt < 2; ++dt) {
      bf16x8 vf = *(const bf16x8*)(VTs + (32 * dt + r) * 72 + 32 * ks + 16 * sp + 8 * hh);
      o[dt] = MFMA32(vf, pf, o[dt]);
    }
  }
}

DI void nsa_tile64_fast(const bf16_t* Ks, const bf16_t* VTs, int r, int hh, const bf16x8 (&qf)[4], float init,
                        f32x16 (&o)[2], float& lsum) {
  f32x16 sa, sb;
#pragma unroll
  for (int i = 0; i < 16; ++i) { sa[i] = init; sb[i] = init; }
#pragma unroll
  for (int k = 0; k < 4; ++k) {
    bf16x8 a1 = *(const bf16x8*)(Ks + r * 72 + k * 16 + hh * 8);
    bf16x8 a2 = *(const bf16x8*)(Ks + (32 + r) * 72 + k * 16 + hh * 8);
    sa = MFMA32(a1, qf[k], sa);
    sb = MFMA32(a2, qf[k], sb);
  }
  float la = 0.f, lb = 0.f;
#pragma unroll
  for (int i = 0; i < 16; ++i) { float pa = fast_exp2(sa[i]); sa[i] = pa; la += pa; }
#pragma unroll
  for (int i = 0; i < 16; ++i) { float pb = fast_exp2(sb[i]); sb[i] = pb; lb += pb; }
  lsum += la + lb;
#pragma unroll
  for (int sp = 0; sp < 2; ++sp) {
    bf16x8 pfa = pack8(sa, sp), pfb = pack8(sb, sp);
#pragma unroll
    for (int dt = 0; dt < 2; ++dt) {
      bf16x8 va = *(const bf16x8*)(VTs + (32 * dt + r) * 72 + 16 * sp + 8 * hh);
      bf16x8 vb = *(const bf16x8*)(VTs + (32 * dt + r) * 72 + 32 + 16 * sp + 8 * hh);
      o[dt] = MFMA32(va, pfa, o[dt]);
      o[dt] = MFMA32(vb, pfb, o[dt]);
    }
  }
}

DI void nsa_tile(const Params& p, int l, int bg, int qt, char* smem) {
  bf16_t* Ks = (bf16_t*)smem; bf16_t* VTs = Ks + 2 * 64 * 72;
  float* impm = (float*)(smem + 36864); float* impt = impm + 32 * 132;
  const int tid = tidx(), lane = tid & 63, wave = tid >> 6, r = lane & 31, hh = lane >> 5;
  char* ws = p.ws;
  const int b = bg >> 1, g = bg & 1;
  const int q0 = qt * 32, cur = q0 >> 6, ql = 8 * wave + (r & 7), q = q0 + ql, hd = r >> 3;
  const size_t tok = (size_t)b * SEQ + q;
  bf16x8 qf[4];
  {
    const bf16_t* qrow = (const bf16_t*)(ws + OFF_QB) + tok * 512 + g * 256 + hd * 64;
#pragma unroll
    for (int s = 0; s < 4; ++s) qf[s] = *(const bf16x8*)(qrow + s * 16 + hh * 8);
  }
  float gc, gs, gw;
  {
    const bf16_t* gp = (const bf16_t*)(ws + OFF_BGT) + tok * 32 + g * 12 + hd * 3;
    gc = bf2f(gp[0]); gs = bf2f(gp[1]); gw = bf2f(gp[2]);
  }
  __syncthreads();
  for (int i = tid; i < 2 * 32 * 132; i += 256) impm[i] = 0.f;
  const int ncb = 2 * qt + 1, nct = (ncb + 63) >> 6;
  const bf16_t* KCb = (const bf16_t*)(ws + OFF_KC) + (size_t)bg * 512 * 64;
  const bf16_t* VCTb = (const bf16_t*)(ws + OFF_VCT) + (size_t)bg * 64 * 512;
  float lc = 0.f;
  for (int kt = 0; kt < nct; ++kt) {
    const int n0 = kt * 64;
    __syncthreads();
    nsa_load_kv(Ks, VTs, KCb + (size_t)n0 * 64, VCTb + n0, 512, false);
    __syncthreads();
#pragma unroll
    for (int ks = 0; ks < 2; ++ks)
      if (n0 + 32 * ks < ncb) {
        f32x16 s = nsa_scores(Ks, ks, r, hh, qf);
#pragma unroll
        for (int i = 0; i < 16; ++i) {
          int n = n0 + 32 * ks + crow(i, hh);
          lc += (16 * n + 31 <= q) ? fast_exp2(s[i]) : 0.f;
        }
      }
  }
  lc += __shfl_xor(lc, 32);
  const float linv = lc > 0.f ? 1.f / lc : 0.f;
  f32x16 fin[2], oc[2];
  oc[0] = zero16(); oc[1] = zero16();
  for (int kt = 0; kt < nct; ++kt) {
    const int n0 = kt * 64;
    __syncthreads();
    nsa_load_kv(Ks, VTs, KCb + (size_t)n0 * 64, VCTb + n0, 512, true);
    __syncthreads();
#pragma unroll
    for (int ks = 0; ks < 2; ++ks)
      if (n0 + 32 * ks < ncb) {
        f32x16 s = nsa_scores(Ks, ks, r, hh, qf);
#pragma unroll
        for (int i = 0; i < 16; ++i) {
          int n = n0 + 32 * ks + crow(i, hh);
          s[i] = (16 * n + 31 <= q) ? fast_exp2(s[i]) * linv : 0.f;
        }
#pragma unroll
        for (int ig = 0; ig < 4; ++ig) {
          float tl = 0.5f * s[4 * ig + 3];
          float mn = s[4 * ig] + s[4 * ig + 1] + s[4 * ig + 2] + tl;
          mn += __shfl_xor(mn, 8); mn += __shfl_xor(mn, 16);
          tl += __shfl_xor(tl, 8); tl += __shfl_xor(tl, 16);
          if (hd == 0) {
            int sidx = (n0 >> 2) + 8 * ks + 2 * ig + hh;
            impm[ql * 132 + sidx] = mn;
            impt[ql * 132 + sidx + 1] = tl;
          }
        }
        nsa_pv(VTs, ks, r, hh, s, oc);
      }
  }
#pragma unroll
  for (int dt = 0; dt < 2; ++dt)
#pragma unroll
    for (int i = 0; i < 16; ++i) fin[dt][i] = gc * oc[dt][i];
  __syncthreads();
  unsigned long long mylo = 0ull, myhi = 0ull;
  if (cur <= 15) {
    mylo = (2ull << cur) - 1ull;
  } else {
    for (int qi = 0; qi < 8; ++qi) {
      const float* im = impm + (8 * wave + qi) * 132; const float* it = impt + (8 * wave + qi) * 132;
      const int s0 = lane, s1 = lane + 64;
      float v0 = im[s0] + it[s0], v1 = im[s1] + it[s1];
      unsigned k0 = (s0 >= 1 && s0 <= cur - 2) ? __float_as_uint(v0) + 1u : 0u;
      unsigned k1 = (s1 <= cur - 2) ? __float_as_uint(v1) + 1u : 0u;
      unsigned T = 0u;
      for (int bit = 31; bit >= 0; --bit) {
        unsigned cand = T | (1u << bit);
        int cnt = __popcll(__ballot(k0 >= cand)) + __popcll(__ballot(k1 >= cand));
        if (cnt >= 13) { T = cand; if (cnt == 13) break; }
      }
      unsigned long long g0 = __ballot(k0 > T), g1 = __ballot(k1 > T);
      unsigned long long e0 = __ballot(k0 == T), e1 = __ballot(k1 == T);
      int need = 13 - __popcll(g0) - __popcll(g1);
      while (need > 0 && e0) { unsigned long long lb = e0 & (~e0 + 1ull); g0 |= lb; e0 ^= lb; --need; }
      while (need > 0 && e1) { unsigned long long lb = e1 & (~e1 + 1ull); g1 |= lb; e1 ^= lb; --need; }
      g0 |= 1ull;
      if (cur - 1 < 64) g0 |= 1ull << (cur - 1); else g1 |= 1ull << (cur - 1 - 64);
      if (cur < 64) g0 |= 1ull << cur; else g1 |= 1ull << (cur - 64);
      if ((r & 7) == qi) { mylo = g0; myhi = g1; }
    }
  }
  {
    f32x16 os[2]; os[0] = zero16(); os[1] = zero16();
    float ls = 0.f;
    const bf16_t* KSb = (const bf16_t*)(ws + OFF_KS) + (size_t)bg * SEQ * 64;
    const bf16_t* VSTb = (const bf16_t*)(ws + OFF_VST) + (size_t)bg * 64 * SEQ;
    auto slc_compute = [&](int j, const bf16_t* KsP, const bf16_t* VTsP) {
      const bool mysel = (j < 64 ? (mylo >> j) : (myhi >> (j - 64))) & 1ull;
      if (__ballot(mysel) != 0ull) {
        if (j < cur) nsa_tile64_fast(KsP, VTsP, r, hh, qf, mysel ? 0.f : -1e30f, os, ls);
        else
#pragma unroll
        for (int ks = 0; ks < 2; ++ks) {
          const int kb = j * 64 + 32 * ks;
          if (kb <= q0 + 31) {
            f32x16 s = nsa_scores(KsP, ks, r, hh, qf, mysel ? 0.f : -1e30f);
            if (j == cur) {
#pragma unroll
              for (int i = 0; i < 16; ++i) {
                float pv = (kb + crow(i, hh) <= q) ? fast_exp2(s[i]) : 0.f;
                s[i] = pv; ls += pv;
              }
            } else {
              float la = 0.f, lb = 0.f;
#pragma unroll
              for (int i = 0; i < 16; i += 2) {
                float p1 = fast_exp2(s[i]), p2 = fast_exp2(s[i + 1]);
                s[i] = p1; s[i + 1] = p2; la += p1; lb += p2;
              }
              ls += la + lb;
            }
            nsa_pv(VTsP, ks, r, hh, s, os);
          }
        }
      }
    };
    u32x4 prk[4], prv[4];
    const int plr = tid >> 3, pcc = tid & 7;
    auto slc_issue = [&](int j) {
      const int j1 = (j + 1 <= cur) ? j + 1 : j;
#pragma unroll
      for (int i = 0; i < 2; ++i) {
        const int row = plr + 32 * i;
        prk[i] = *(const u32x4*)(KSb + ((size_t)j * 64 + row) * 64 + pcc * 8);
        prk[2 + i] = *(const u32x4*)(KSb + ((size_t)j1 * 64 + row) * 64 + pcc * 8);
        prv[i] = *(const u32x4*)(VSTb + (size_t)row * SEQ + j * 64 + pcc * 8);
        prv[2 + i] = *(const u32x4*)(VSTb + (size_t)row * SEQ + j1 * 64 + pcc * 8);
      }
    };
    slc_issue(0);
    for (int j = 0; j <= cur; j += 2) {
      const bool two = (j + 1 <= cur);
      __syncthreads();
#pragma unroll
      for (int i = 0; i < 2; ++i) {
        const int row = plr + 32 * i;
        *(u32x4*)(Ks + row * 72 + pcc * 8) = prk[i];
        *(u32x4*)(Ks + 64 * 72 + row * 72 + pcc * 8) = prk[2 + i];
        bf16_t* d0 = VTs + row * 72 + (pcc >> 1) * 16 + (pcc & 1) * 4;
        *(uint2*)d0 = make_uint2(prv[i][0], prv[i][1]); *(uint2*)(d0 + 8) = make_uint2(prv[i][2], prv[i][3]);
        bf16_t* d1 = d0 + 64 * 72;
        *(uint2*)d1 = make_uint2(prv[2 + i][0], prv[2 + i][1]); *(uint2*)(d1 + 8) = make_uint2(prv[2 + i][2], prv[2 + i][3]);
      }
      __syncthreads();
      if (j + 2 <= cur) slc_issue(j + 2);
      __builtin_amdgcn_sched_barrier(0);
      slc_compute(j, Ks, VTs);
      if (two) slc_compute(j + 1, Ks + 64 * 72, VTs + 64 * 72);
    }
    ls += __shfl_xor(ls, 32);
    const float cs = gs / ls;
#pragma unroll
    for (int dt = 0; dt < 2; ++dt)
#pragma unroll
      for (int i = 0; i < 16; ++i) fin[dt][i] += cs * os[dt][i];
  }
  {
    f32x16 ow[2]; ow[0] = zero16(); ow[1] = zero16();
    float lw = 0.f;
    const bf16_t* KWb = (const bf16_t*)(ws + OFF_KW) + (size_t)bg * SEQ * 64;
    const bf16_t* VWTb = (const bf16_t*)(ws + OFF_VWT) + (size_t)bg * 64 * SEQ;
    const int lo = q0 - 511;
    const int kt_lo = (lo > 0 ? lo : 0) >> 6;
    auto win_compute = [&](int kt, const bf16_t* KsP, const bf16_t* VTsP) {
      const int qw0f = q0 + 8 * wave;
      if (kt * 64 + 63 <= qw0f && kt * 64 > qw0f + 7 - 512) { nsa_tile64_fast(KsP, VTsP, r, hh, qf, 0.f, ow, lw); return; }
#pragma unroll
      for (int ks = 0; ks < 2; ++ks) {
        const int kb = kt * 64 + 32 * ks;
        if (kb <= q0 + 31 && kb + 31 > q0 - 512) {
          f32x16 s = nsa_scores(KsP, ks, r, hh, qf);
          const int qw0 = q0 + 8 * wave;
          if (kb + 31 <= qw0 && kb > qw0 + 7 - 512) {
            float la = 0.f, lb = 0.f;
#pragma unroll
            for (int i = 0; i < 16; i += 2) {
              float p1 = fast_exp2(s[i]), p2 = fast_exp2(s[i + 1]);
              s[i] = p1; s[i + 1] = p2; la += p1; lb += p2;
            }
            lw += la + lb;
          } else {
#pragma unroll
            for (int i = 0; i < 16; ++i) {
              int key = kb + crow(i, hh);
              float pv = (key <= q && key > q - 512) ? fast_exp2(s[i]) : 0.f;
              s[i] = pv; lw += pv;
            }
          }
          nsa_pv(VTsP, ks, r, hh, s, ow);
        }
      }
    };
    for (int kt = kt_lo; kt <= cur; kt += 2) {
      const bool two = (kt + 1 <= cur);
      __syncthreads();
      const int kt1 = two ? kt + 1 : kt;
      nsa_load_kv2(Ks, VTs, KWb + (size_t)kt * 64 * 64, VWTb + kt * 64, KWb + (size_t)kt1 * 64 * 64, VWTb + kt1 * 64, SEQ);
      __syncthreads();
      win_compute(kt, Ks, VTs);
      if (two) win_compute(kt + 1, Ks + 64 * 72, VTs + 64 * 72);
    }
    lw += __shfl_xor(lw, 32);
    const float cw = gw / lw;
#pragma unroll
    for (int dt = 0; dt < 2; ++dt)
#pragma unroll
      for (int i = 0; i < 16; ++i) fin[dt][i] += cw * ow[dt][i];
  }
  bf16_t* gb = (bf16_t*)(ws + OFF_GB) + tok * 512 + g * 256 + hd * 64;
#pragma unroll
  for (int dt = 0; dt < 2; ++dt)
#pragma unroll
    for (int ig = 0; ig < 4; ++ig) {
      const int dv = 32 * dt + 8 * ig + 4 * hh;
      uint2 gate = *(const uint2*)(gb + dv);
      float y0 = fin[dt][4 * ig + 0] * bflo(gate.x), y1 = fin[dt][4 * ig + 1] * bfhi(gate.x);
      float y2 = fin[dt][4 * ig + 2] * bflo(gate.y), y3 = fin[dt][4 * ig + 3] * bfhi(gate.y);
      *(uint2*)(gb + dv) = make_uint2(pk2(y0, y1), pk2(y2, y3));
    }
}

DI void merge_tile(const Params& p, int l, int rt, int ct, char* smem) {
  const int tid = tidx(), lane = tid & 63, wave = tid >> 6, r = lane & 31, hh = lane >> 5, wm = wave >> 1, wn = wave & 1;
  char* ws = p.ws;
  f32x16 mg[2][2];
#pragma unroll
  for (int a = 0; a < 2; ++a) for (int b = 0; b < 2; ++b) mg[a][b] = zero16();
  const bf16_t* H = (const bf16_t*)(ws + OFF_H) + (size_t)rt * 128 * 1024;
  const bf16_t* WIN = (const bf16_t*)(ws + OFF_WIN + l * SZ_WIN_L) + (size_t)4992 * 1024;
  const bf16_t* WB = (const bf16_t*)(ws + OFF_WB + l * SZ_WB_L);
#pragma unroll 1
  for (int br = 0; br < 3; ++br) {
    unsigned* gst = (unsigned*)(smem + 36864) + tid;
    {
      f32x16 acc[2][2];
#pragma unroll
      for (int a = 0; a < 2; ++a) for (int b = 0; b < 2; ++b) acc[a][b] = zero16();
      gemm128_nt<2>(H, 1024, 127, WIN + ((size_t)br * 1024 + ct * 128) * 1024, 1024, 1024, acc, smem);
#pragma unroll
      for (int a = 0; a < 2; ++a)
#pragma unroll
        for (int b = 0; b < 2; ++b)
#pragma unroll
          for (int i = 0; i < 8; ++i) gst[((a * 2 + b) * 8 + i) * 256] = pk2(sigmoidf_(acc[a][b][2 * i]), sigmoidf_(acc[a][b][2 * i + 1]));
    }
    {
      f32x16 acc[2][2];
#pragma unroll
      for (int a = 0; a < 2; ++a) for (int b = 0; b < 2; ++b) acc[a][b] = zero16();
      const bf16_t* U = (const bf16_t*)(ws + (br == 0 ? OFF_GA : (br == 1 ? OFF_GB : OFF_GC))) + (size_t)rt * 128 * 512;
      gemm128_nt<2>(U, 512, 127, WB + ((size_t)br * 1024 + ct * 128) * 512, 512, 512, acc, smem);
#pragma unroll
      for (int a = 0; a < 2; ++a)
#pragma unroll
        for (int b = 0; b < 2; ++b)
#pragma unroll
          for (int i = 0; i < 8; ++i) {
            const unsigned gv = gst[((a * 2 + b) * 8 + i) * 256];
            mg[a][b][2 * i] += bflo(gv) * acc[a][b][2 * i];
            mg[a][b][2 * i + 1] += bfhi(gv) * acc[a][b][2 * i + 1];
          }
    }
  }
  bf16_t* M = (bf16_t*)(ws + OFF_MERGED);
#pragma unroll
  for (int a = 0; a < 2; ++a)
#pragma unroll
    for (int b = 0; b < 2; ++b)
#pragma unroll
      for (int i = 0; i < 16; ++i) {
        const int row = rt * 128 + wm * 64 + a * 32 + crow(i, hh), col = ct * 128 + wn * 64 + b * 32 + r;
        M[(size_t)row * 1024 + col] = f2bf(mg[a][b][i]);
      }
}

DI void outproj_tile(const Params& p, int l, int rt, int ct, char* smem) {
  const int tid = tidx(), lane = tid & 63, wave = tid >> 6, r = lane & 31, hh = lane >> 5, wm = wave >> 1, wn = wave & 1;
  char* ws = p.ws;
  f32x16 acc[4][2];
#pragma unroll
  for (int a = 0; a < 4; ++a) for (int b = 0; b < 2; ++b) acc[a][b] = zero16();
  gemm_nt<3, 4>((const bf16_t*)(ws + OFF_MERGED) + (size_t)rt * 256 * 1024, 1024, 255,
                (const bf16_t*)(ws + OFF_WO + l * SZ_WO_L) + (size_t)ct * 128 * 1024, 1024, 1024, acc, smem);
  const float* xin = l == 0 ? p.x : p.out;
#pragma unroll
  for (int a = 0; a < 4; ++a)
#pragma unroll
    for (int b = 0; b < 2; ++b) {
      const size_t base = (size_t)(rt * 256 + wm * 128 + a * 32) * 1024 + ct * 128 + wn * 64 + b * 32 + r;
      float xv[16];
#pragma unroll
      for (int i = 0; i < 16; ++i) xv[i] = xin[base + (size_t)crow(i, hh) * 1024];
      __builtin_amdgcn_sched_barrier(0);
#pragma unroll
      for (int i = 0; i < 16; ++i) p.out[base + (size_t)crow(i, hh) * 1024] = xv[i] + acc[a][b][i];
    }
}

DI unsigned xb_ld(unsigned* p) { return __hip_atomic_load(p, __ATOMIC_RELAXED, __HIP_MEMORY_SCOPE_AGENT); }
DI unsigned xb_add(unsigned* p, unsigned v) { return __hip_atomic_fetch_add(p, v, __ATOMIC_RELAXED, __HIP_MEMORY_SCOPE_AGENT); }
DI void grid_barrier(unsigned* ctr, unsigned target) {
  asm volatile("s_waitcnt vmcnt(0)" ::: "memory");
  __syncthreads();
  if (tidx() == 0) {
    __builtin_amdgcn_fence(__ATOMIC_RELEASE, "agent");
    asm volatile("s_waitcnt vmcnt(0)" ::: "memory");
    xb_add(ctr, 1u);
    unsigned spins = 0;
    while (xb_ld(ctr) < target && spins < (1u << 22)) { __builtin_amdgcn_s_sleep(2); ++spins; }
    __builtin_amdgcn_fence(__ATOMIC_ACQUIRE, "agent");
    asm volatile("s_waitcnt vmcnt(0)" ::: "memory");
  }
  __syncthreads();
}

DI void xcd_barrier(unsigned* bar, unsigned xcc, const volatile int* xinfo, unsigned k) {
  asm volatile("s_waitcnt vmcnt(0)" ::: "memory");
  __syncthreads();
  if (tidx() == 0) {
    const unsigned nloc = (unsigned)xinfo[2], nx = (unsigned)xinfo[3];
    unsigned* xsub = bar + 512 + 64 * xcc; unsigned* xgen = bar + 1536 + 64 * xcc;
    unsigned* top = bar + 2560; unsigned* topgen = bar + 2624;
    const unsigned old = xb_add(xsub, 1u);
    unsigned spins = 0;
    if (old + 1u == k * nloc) {
      __builtin_amdgcn_fence(__ATOMIC_RELEASE, "agent");
      asm volatile("s_waitcnt vmcnt(0)" ::: "memory");
      const unsigned og = xb_add(top, 1u);
      if (og + 1u == k * nx) xb_add(topgen, 1u);
      else while (xb_ld(topgen) < k && spins < (1u << 22)) { __builtin_amdgcn_s_sleep(1); ++spins; }
      __builtin_amdgcn_fence(__ATOMIC_ACQUIRE, "agent");
      xb_add(xgen, 1u);
      asm volatile("s_waitcnt vmcnt(0)" ::: "memory");
    } else {
      while (xb_ld(xgen) < k && spins < (1u << 22)) { __builtin_amdgcn_s_sleep(1); ++spins; }
      __builtin_amdgcn_fence(__ATOMIC_ACQUIRE, "agent");
      asm volatile("s_waitcnt vmcnt(0)" ::: "memory");
    }
  }
  __syncthreads();
}

DI float wave_sum(float v) {
#pragma unroll
  for (int o = 32; o >= 1; o >>= 1) v += __shfl_xor(v, o);
  return v;
}

template <int PH>
DI void run_phase(const Params& p, int l, char* smem) {
  const int G = gridDim.x, bid = blockIdx.x;
  if (PH == 0) {
    const int nprep = l == 0 ? 2 * PREP_L : 0;
    for (int t = bid; t < nprep + 1024; t += G) {
      if (t < nprep) prep_tile(p, t, smem); else norm_tile(p, l, t - nprep);
    }
  } else if (PH == 1) {
    const int xcd = bid & 7, slot = bid >> 3, nslot = G >> 3;
    for (int st = xcd; st < 8 * 5; st += 8) {
      const int str = st & 7, stc = st >> 3;
      for (int s = slot; s < 64; s += nslot) {
        const int rt = str * 8 + (s & 7), ct = stc * 8 + (s >> 3);
        if (ct < 39) inproj_tile(p, l, rt, ct, smem);
      }
    }
  } else if (PH == 2) {
    const float lam_init = 0.8f - 0.6f * __expf(-0.3f * (float)l);
    const int lane = tidx() & 63;
    const float* lp = p.a_lam + l * 256;
    const float d1 = wave_sum(lp[lane] * lp[64 + lane]), d2 = wave_sum(lp[128 + lane] * lp[192 + lane]);
    const float lam = __expf(d1) - __expf(d2) + lam_init;
    if (G == 512) {
      const int bin = bid;
      unsigned long long ilo = 0ull, ihi = 0ull; int nit = 0;
      auto push = [&](int bh, int c) {
        const unsigned long long e = (unsigned long long)(bh | ((c - 1) << 3));
        if (nit < 6) ilo |= e << (10 * nit); else ihi |= e << (10 * (nit - 6));
        ++nit;
      };
      if (bin < 32) {
        push(bin & 7, 86 + (bin >> 3));
      } else if (bin < 344) {
        const int i = bin - 32; push(i & 7, 128 - (i >> 3)); push(i & 7, 4 + (i >> 3));
      } else if (bin < 496) {
        const int i = bin - 344; push(i & 7, 85 - (i >> 3)); push(i & 7, 47 + (i >> 3));
      } else if (bin < 500) {
        const int n = bin - 496; push(2 * n, 66); push(2 * n + 1, 66);
      } else {
        const int n = bin - 500;
        if (n < 8) {
          for (int k = 0; k < 3; ++k) { const int m = 3 * n + k; push(m >> 2, 43 + (m & 3)); }
        } else {
          for (int k = 0; k < 2; ++k) { const int m = 24 + 2 * (n - 8) + k; push(m >> 2, 43 + (m & 3)); }
          for (int k = 0; k < 6; ++k) { const int s = 6 * (n - 8) + k; push(s & 7, 1 + (s >> 3)); }
        }
      }
      for (int k = 0; k < nit; ++k) {
        const int e = (int)(((k < 6 ? ilo >> (10 * k) : ihi >> (10 * (k - 6)))) & 1023ull);
        diff_tile(p, l, (e & 7) >> 2, e & 3, e >> 3, lam, lam_init, smem);
      }
      if (bin < 32) compress_tile(p, l, bin, smem);
      pool_tile(p, l, bin >> 2, bin & 3, smem);
    } else {
      for (int t = bid; t < 512; t += G) {
        const int bh = t & 7, pp = (t >> 3) & 63;
        diff_tile(p, l, bh >> 2, bh & 3, 127 - pp, lam, lam_init, smem);
        diff_tile(p, l, bh >> 2, bh & 3, pp, lam, lam_init, smem);
      }
      const int b2 = (bid + G - (512 % G)) % G;
      for (int t = b2; t < 32; t += G) compress_tile(p, l, t, smem);
      const int b3 = (b2 + G - (32 % G)) % G;
      for (int u = b3; u < 512; u += G) pool_tile(p, l, u >> 2, u & 3, smem);
    }
  } else if (PH == 3) {
    int k = 0;
    for (int base = 0; base < 1024; base += G, ++k) {
      int t = (k & 1) ? base + (G - 1 - bid) : base + bid;
      if (t < 1024) {
        const int qt = 255 - (t >> 2), bg = t & 3;
        nsa_tile(p, l, bg, qt, smem);
      }
    }
  } else if (PH == 4) {
    const int xcd = bid & 7, slot = bid >> 3, nslot = G >> 3;
    for (int st = xcd; st < 16; st += 8) {
      for (int s = slot; s < 64; s += nslot) {
        const int rt = st * 8 + (s & 7), ct = s >> 3;
        merge_tile(p, l, rt, ct, smem);
      }
    }
  } else if (PH == 5) {
    const int xcd = bid & 7, slot = bid >> 3, nslot = G >> 3;
    for (int s = slot; s < 64; s += nslot) {
      const int rt = xcd * 8 + (s & 7), ct = s >> 3;
      outproj_tile(p, l, rt, ct, smem);
    }
  }
}

#if MK_ONE_LAUNCH
#define AS1 __attribute__((address_space(1)))
#define AS4 __attribute__((address_space(4)))
struct ParamsD {
  AS1 const float* x; AS1 const float* norm_g; AS1 const float* w_in; AS1 const float* a_q_g; AS1 const float* a_k_g; AS1 const float* a_lam;
  AS1 const float* a_subln_g; AS1 const float* b_q_g; AS1 const float* b_k_g; AS1 const float* b_cmp_pos; AS1 const float* b_phi_w1;
  AS1 const float* b_phi_w2; AS1 const float* c_w; AS1 const float* c_scale; AS1 const float* w_branch; AS1 const float* w_out;
  AS1 float* out; AS1 char* ws;
};
template <int PH>
DI void phase_opaque(int l, char* smem) {
  size_t z = 0;
  asm volatile("" : "+s"(l));
  asm volatile("" : "+s"(z));
  const AS4 ParamsD* kd = (const AS4 ParamsD*)((const AS4 char*)__builtin_amdgcn_kernarg_segment_ptr() + z);
  Params p;
  p.x = (const float*)kd->x; p.norm_g = (const float*)kd->norm_g; p.w_in = (const float*)kd->w_in;
  p.a_q_g = (const float*)kd->a_q_g; p.a_k_g = (const float*)kd->a_k_g; p.a_lam = (const float*)kd->a_lam;
  p.a_subln_g = (const float*)kd->a_subln_g; p.b_q_g = (const float*)kd->b_q_g; p.b_k_g = (const float*)kd->b_k_g;
  p.b_cmp_pos = (const float*)kd->b_cmp_pos; p.b_phi_w1 = (const float*)kd->b_phi_w1; p.b_phi_w2 = (const float*)kd->b_phi_w2;
  p.c_w = (const float*)kd->c_w; p.c_scale = (const float*)kd->c_scale; p.w_branch = (const float*)kd->w_branch;
  p.w_out = (const float*)kd->w_out; p.out = (float*)kd->out; p.ws = (char*)kd->ws;
  run_phase<PH>(p, l, smem);
}
__global__ void __launch_bounds__(256, 2) mega_kernel(Params p) {
  __shared__ __attribute__((aligned(16))) char smem[SMEM_BYTES];
  __shared__ int xinfo_s[4];
  volatile int* xinfo = xinfo_s;
  unsigned* bar = (unsigned*)(p.ws + OFF_BAR);
  const unsigned xcc = (unsigned)__builtin_amdgcn_s_getreg((3 << 11) | 20) & 0xFu;
  if (tidx() == 0) xb_add(&bar[64 + 16 * xcc], 1u);
  phase_opaque<0>(0, smem);
  grid_barrier(bar, gridDim.x);
  if (tidx() == 0) {
    int nx = 0, mine = 1;
    for (unsigned j = 0; j < 16; ++j) {
      const unsigned c = xb_ld(&bar[64 + 16 * j]);
      if (c > 0) ++nx;
      if (j == xcc) mine = (int)c;
    }
    xinfo[2] = mine; xinfo[3] = nx;
  }
  __syncthreads();
  phase_opaque<1>(0, smem); xcd_barrier(bar, xcc, xinfo, 1);
  phase_opaque<2>(0, smem); xcd_barrier(bar, xcc, xinfo, 2);
  phase_opaque<3>(0, smem); xcd_barrier(bar, xcc, xinfo, 3);
  phase_opaque<4>(0, smem); xcd_barrier(bar, xcc, xinfo, 4);
  phase_opaque<5>(0, smem); xcd_barrier(bar, xcc, xinfo, 5);
  phase_opaque<0>(1, smem); xcd_barrier(bar, xcc, xinfo, 6);
  phase_opaque<1>(1, smem); xcd_barrier(bar, xcc, xinfo, 7);
  phase_opaque<2>(1, smem); xcd_barrier(bar, xcc, xinfo, 8);
  phase_opaque<3>(1, smem); xcd_barrier(bar, xcc, xinfo, 9);
  phase_opaque<4>(1, smem); xcd_barrier(bar, xcc, xinfo, 10);
  phase_opaque<5>(1, smem);
}
#else
template <int PH>
__global__ void __launch_bounds__(256, 2) phase_kernel(Params p, int l) {
  __shared__ __attribute__((aligned(16))) char smem[SMEM_BYTES];
  run_phase<PH>(p, l, smem);
}
#endif

extern "C" void kernel_launch(void* const* d_in, const int* in_sizes, int n_in, void* d_out, int out_size, void* d_ws,
                              size_t ws_size, hipStream_t stream) {
  if (ws_size < WS_TOTAL) { fprintf(stderr, "workspace too small: %zu < %zu\n", ws_size, (size_t)WS_END); return; }
  Params p{};
  p.x = (const float*)d_in[0]; p.norm_g = (const float*)d_in[1]; p.w_in = (const float*)d_in[2];
  p.a_q_g = (const float*)d_in[3]; p.a_k_g = (const float*)d_in[4]; p.a_lam = (const float*)d_in[5];
  p.a_subln_g = (const float*)d_in[6]; p.b_q_g = (const float*)d_in[7]; p.b_k_g = (const float*)d_in[8];
  p.b_cmp_pos = (const float*)d_in[9]; p.b_phi_w1 = (const float*)d_in[10]; p.b_phi_w2 = (const float*)d_in[11];
  p.c_w = (const float*)d_in[12]; p.c_scale = (const float*)d_in[13]; p.w_branch = (const float*)d_in[14];
  p.w_out = (const float*)d_in[15];
  p.out = (float*)d_out; p.ws = (char*)d_ws;
#if MK_ONE_LAUNCH
  static int grid_blocks = 0;
  if (!grid_blocks) {
    int dev = 0, cus = 0, per_cu = 0;
    (void)hipGetDevice(&dev);
    (void)hipDeviceGetAttribute(&cus, hipDeviceAttributeMultiprocessorCount, dev);
    (void)hipOccupancyMaxActiveBlocksPerMultiprocessor(&per_cu, mega_kernel, 256, 0);
    if (per_cu > 2) per_cu = 2;
    if (per_cu < 1) per_cu = 1;
    grid_blocks = cus * per_cu;
  }
  (void)hipMemsetAsync((char*)d_ws + OFF_BAR, 0, 16384, stream);
  void* args[] = {&p};
  hipError_t e = hipLaunchCooperativeKernel((void*)mega_kernel, dim3(grid_blocks), dim3(256), args, 0, stream);
  if (e != hipSuccess) fprintf(stderr, "cooperative launch failed: %s (grid %d)\n", hipGetErrorString(e), grid_blocks);
#else
  const int G = 512;
  for (int l = 0; l < 2; ++l) {
    phase_kernel<0><<<G, 256, 0, stream>>>(p, l);
    phase_kernel<1><<<G, 256, 0, stream>>>(p, l);
    phase_kernel<2><<<G, 256, 0, stream>>>(p, l);
    phase_kernel<3><<<G, 256, 0, stream>>>(p, l);
    phase_kernel<4><<<G, 256, 0, stream>>>(p, l);
    phase_kernel<5><<<G, 256, 0, stream>>>(p, l);
  }
#endif
}
```

```cpp
#include <hip/hip_runtime.h>
#include <hip/hip_cooperative_groups.h>
#include <stdint.h>
#include <stdio.h>
namespace cg = cooperative_groups;

#ifndef MK_ONE_LAUNCH
#define MK_ONE_LAUNCH 1
#endif

typedef unsigned short bf16_t;
typedef __attribute__((ext_vector_type(8))) short bf16x8;
typedef __attribute__((ext_vector_type(4))) short s16x4;
typedef __attribute__((ext_vector_type(16))) float f32x16;
typedef __attribute__((ext_vector_type(2))) __bf16 bf2_t;
typedef __attribute__((ext_vector_type(2))) float f2_t;
typedef __attribute__((ext_vector_type(4))) unsigned u32x4;

#define DI __device__ __forceinline__
#define MFMA32(a, b, c) __builtin_amdgcn_mfma_f32_32x32x16_bf16((a), (b), (c), 0, 0, 0)

constexpr int T_TOK = 16384, SEQ = 8192, DM = 1024, NIN = 7960;
constexpr float EPS = 1e-6f;
constexpr float QSCALE = 0.125f * 1.4426950408889634f;

constexpr size_t SZ_WIN_L = (size_t)8064 * 1024 * 2;
constexpr size_t SZ_WB_L = (size_t)3 * 1024 * 512 * 2;
constexpr size_t SZ_WO_L = (size_t)1024 * 1024 * 2;
constexpr size_t SZ_W1_L = (size_t)2 * 256 * 2048 * 2;
constexpr size_t SZ_W2_L = (size_t)2 * 64 * 256 * 2;
constexpr size_t SZ_CW_L = (size_t)4 * 128 * 128 * 2;
constexpr size_t SZ_512 = (size_t)T_TOK * 512 * 2;
constexpr size_t SZ_KS = (size_t)4 * SEQ * 64 * 2;
constexpr size_t OFF_WIN = 0;
constexpr size_t OFF_WB = OFF_WIN + 2 * SZ_WIN_L;
constexpr size_t OFF_WO = OFF_WB + 2 * SZ_WB_L;
constexpr size_t OFF_W1 = OFF_WO + 2 * SZ_WO_L;
constexpr size_t OFF_W2 = OFF_W1 + 2 * SZ_W1_L;
constexpr size_t OFF_CW = OFF_W2 + 2 * SZ_W2_L;
constexpr size_t OFF_B1 = OFF_CW + 2 * SZ_CW_L;
constexpr size_t OFF_H = OFF_B1 + 4096;
constexpr size_t OFF_QA = OFF_H + (size_t)T_TOK * 1024 * 2;
constexpr size_t OFF_KA = OFF_QA + SZ_512;
constexpr size_t OFF_VAT = OFF_KA + SZ_512;
constexpr size_t OFF_GA = OFF_VAT + SZ_512;
constexpr size_t OFF_QB = OFF_GA + SZ_512;
constexpr size_t OFF_CKV = OFF_QB + SZ_512;
constexpr size_t OFF_KS = OFF_CKV + 2 * SZ_KS;
constexpr size_t OFF_VST = OFF_KS + SZ_KS;
constexpr size_t OFF_KW = OFF_VST + SZ_KS;
constexpr size_t OFF_VWT = OFF_KW + SZ_KS;
constexpr size_t OFF_GB = OFF_VWT + SZ_KS;
constexpr size_t OFF_BGT = OFF_GB + SZ_512;
constexpr size_t OFF_CU = OFF_BGT + (size_t)T_TOK * 32 * 2;
constexpr size_t OFF_GC = OFF_CU + SZ_512;
constexpr size_t OFF_KC = OFF_GC + SZ_512;
constexpr size_t OFF_VCT = OFF_KC + (size_t)4 * 512 * 64 * 2;
constexpr size_t WS_END = OFF_VCT + (size_t)4 * 512 * 64 * 2;
constexpr size_t OFF_BAR = WS_END;
constexpr size_t WS_TOTAL = OFF_BAR + 16384;
constexpr size_t OFF_MERGED = OFF_QA;

constexpr int SMEM_BYTES = 75776;

struct Params {
  const float* x; const float* norm_g; const float* w_in; const float* a_q_g; const float* a_k_g; const float* a_lam;
  const float* a_subln_g; const float* b_q_g; const float* b_k_g; const float* b_cmp_pos; const float* b_phi_w1;
  const float* b_phi_w2; const float* c_w; const float* c_scale; const float* w_branch; const float* w_out;
  float* out; char* ws;
};

DI int tidx() { int t = (int)__builtin_amdgcn_workitem_id_x(); asm volatile("" : "+v"(t)); return t; }
DI unsigned pk2(float a, float b) { f2_t v = {a, b}; return __builtin_bit_cast(unsigned, __builtin_convertvector(v, bf2_t)); }
DI bf16_t f2bf(float a) { return (bf16_t)(pk2(a, 0.f) & 0xffffu); }
DI float bf2f(bf16_t b) { return __uint_as_float(((unsigned)b) << 16); }
DI float bflo(unsigned u) { return __uint_as_float(u << 16); }
DI float bfhi(unsigned u) { return __uint_as_float(u & 0xffff0000u); }
DI int crow(int i, int hh) { return (i & 3) + 8 * (i >> 2) + 4 * hh; }
DI float fast_exp2(float x) { return __builtin_amdgcn_exp2f(x); }
DI float sigmoidf_(float v) { return __builtin_amdgcn_rcpf(1.f + __expf(-v)); }
DI float siluf_(float v) { return v * __builtin_amdgcn_rcpf(1.f + __expf(-v)); }
DI f32x16 zero16() { f32x16 z; _Pragma("unroll") for (int i = 0; i < 16; ++i) z[i] = 0.f; return z; }
DI bf16x8 pack8(const f32x16& x, int s) {
  u32x4 p;
  p[0] = pk2(x[8 * s + 0], x[8 * s + 1]); p[1] = pk2(x[8 * s + 2], x[8 * s + 3]);
  p[2] = pk2(x[8 * s + 4], x[8 * s + 5]); p[3] = pk2(x[8 * s + 6], x[8 * s + 7]);
  return __builtin_bit_cast(bf16x8, p);
}
DI bf16x8 ld_vfrag(const bf16_t* p) {
  s16x4 lo = *(const s16x4*)p, hi = *(const s16x4*)(p + 8);
  return __builtin_shufflevector(lo, hi, 0, 1, 2, 3, 4, 5, 6, 7);
}

DI int win_src_col(int c, int& nvalid) {
  nvalid = 64;
  if (c < 40) return c * 64;
  if (c < 52) return 2560 + (c - 40) * 64;
  if (c < 60) return 3352 + (c - 52) * 64;
  if (c < 68) return 3864 + (c - 60) * 64;
  if (c < 76) return 4376 + (c - 68) * 64;
  if (c == 76) { nvalid = 24; return 3328; }
  if (c == 77) { nvalid = 0; return 0; }
  return 4888 + (c - 78) * 64;
}

template <int KT>
DI void tconv(const float* src, int ld, int nvalid, bf16_t* dst, int ldd, float* sm) {
  const int tid = tidx();
  __syncthreads();
  const int n = tid & 63, kb = tid >> 6;
  float v[KT / 4];
#pragma unroll
  for (int i = 0; i < KT / 4; ++i) v[i] = (n < nvalid) ? src[(size_t)(i * 4 + kb) * ld + n] : 0.f;
#pragma unroll
  for (int i = 0; i < KT / 4; ++i) sm[(i * 4 + kb) * 65 + n] = v[i];
  __syncthreads();
  const int nn = tid >> 2, kq = (tid & 3) * (KT / 4);
  u32x4* d = (u32x4*)(dst + (size_t)nn * ldd + kq);
#pragma unroll
  for (int q = 0; q < KT / 32; ++q) {
    u32x4 o;
#pragma unroll
    for (int i = 0; i < 4; ++i) o[i] = pk2(sm[(kq + 8 * q + 2 * i) * 65 + nn], sm[(kq + 8 * q + 2 * i + 1) * 65 + nn]);
    d[q] = o;
  }
}

constexpr int PREP_WIN = 126 * 4, PREP_WB = 96, PREP_WO = 64, PREP_W1 = 64, PREP_W2 = 2, PREP_CW = 8, PREP_B1 = 32;
constexpr int PREP_L = PREP_WIN + PREP_WB + PREP_WO + PREP_W1 + PREP_W2 + PREP_CW + PREP_B1;

DI void prep_tile(const Params& p, int idx, char* smem) {
  float* sm = (float*)smem;
  const int l = idx / PREP_L;
  int t = idx % PREP_L;
  char* ws = p.ws;
  if (t < PREP_WIN) {
    int c = t >> 2, kp = t & 3, nv; int sc = win_src_col(c, nv);
    tconv<256>(p.w_in + (size_t)l * DM * NIN + (size_t)kp * 256 * NIN + sc, NIN, nv,
               (bf16_t*)(ws + OFF_WIN + l * SZ_WIN_L) + (size_t)c * 64 * 1024 + kp * 256, 1024, sm);
    return;
  }
  t -= PREP_WIN;
  if (t < PREP_WB) {
    int br = t / 32, rem = t % 32, nc = rem >> 1, kp = rem & 1;
    tconv<256>(p.w_branch + ((size_t)(l * 3 + br) * 512 + kp * 256) * 1024 + nc * 64, 1024, 64,
               (bf16_t*)(ws + OFF_WB + l * SZ_WB_L) + ((size_t)br * 1024 + nc * 64) * 512 + kp * 256, 512, sm);
    return;
  }
  t -= PREP_WB;
  if (t < PREP_WO) {
    int nc = t >> 2, kp = t & 3;
    tconv<256>(p.w_out + ((size_t)l * 1024 + kp * 256) * 1024 + nc * 64, 1024, 64,
               (bf16_t*)(ws + OFF_WO + l * SZ_WO_L) + (size_t)nc * 64 * 1024 + kp * 256, 1024, sm);
    return;
  }
  t -= PREP_WO;
  if (t < PREP_W1) {
    int j = t >> 5, rem = t & 31, nc = rem >> 3, kp = rem & 7;
    tconv<256>(p.b_phi_w1 + ((size_t)(l * 2 + j) * 2048 + kp * 256) * 256 + nc * 64, 256, 64,
               (bf16_t*)(ws + OFF_W1 + l * SZ_W1_L) + ((size_t)j * 256 + nc * 64) * 2048 + kp * 256, 2048, sm);
    return;
  }
  t -= PREP_W1;
  if (t < PREP_W2) {
    int j = t;
    tconv<256>(p.b_phi_w2 + (size_t)(l * 2 + j) * 256 * 64, 64, 64,
               (bf16_t*)(ws + OFF_W2 + l * SZ_W2_L) + (size_t)j * 64 * 256, 256, sm);
    return;
  }
  t -= PREP_W2;
  if (t < PREP_CW) {
    int g = t >> 1, nc = t & 1;
    tconv<128>(p.c_w + ((size_t)(l * 4 + g) * 128) * 128 + nc * 64, 128, 64,
               (bf16_t*)(ws + OFF_CW + l * SZ_CW_L) + ((size_t)g * 128 + nc * 64) * 128, 128, sm);
    return;
  }
  t -= PREP_CW;
  {
    const int j = t >> 4, n0 = (t & 15) * 16;
    const int tid = tidx(), n = n0 + (tid & 15), kg = tid >> 4;
    const float* pos = p.b_cmp_pos + (size_t)(l * 2 + j) * 2048;
    const float* w1 = p.b_phi_w1 + (size_t)(l * 2 + j) * 2048 * 256;
    float a0 = 0.f, a1 = 0.f, a2 = 0.f, a3 = 0.f;
#pragma unroll 4
    for (int i = 0; i < 128; i += 4) {
      const int k = kg + 16 * i;
      a0 += pos[k] * w1[(size_t)k * 256 + n];
      a1 += pos[k + 16] * w1[(size_t)(k + 16) * 256 + n];
      a2 += pos[k + 32] * w1[(size_t)(k + 32) * 256 + n];
      a3 += pos[k + 48] * w1[(size_t)(k + 48) * 256 + n];
    }
    __syncthreads();
    sm[tid] = (a0 + a1) + (a2 + a3);
    __syncthreads();
    if (tid < 16) {
      float s = 0.f;
#pragma unroll
      for (int g = 0; g < 16; ++g) s += sm[g * 16 + tid];
      ((float*)(ws + OFF_B1))[(l * 2 + j) * 256 + n0 + tid] = s;
    }
  }
}

DI void norm_tile(const Params& p, int l, int tile) {
  const float* xin = l == 0 ? p.x : p.out;
  const int lane = tidx() & 63, wave = tidx() >> 6;
  bf16_t* H = (bf16_t*)(p.ws + OFF_H);
  const float* g = p.norm_g + l * DM;
  for (int rr = 0; rr < 4; ++rr) {
    int row = tile * 16 + wave * 4 + rr;
    const float4* xr = (const float4*)(xin + (size_t)row * DM);
    float4 v[4]; float ss = 0.f;
#pragma unroll
    for (int i = 0; i < 4; ++i) { v[i] = xr[i * 64 + lane]; ss += v[i].x * v[i].x + v[i].y * v[i].y + v[i].z * v[i].z + v[i].w * v[i].w; }
#pragma unroll
    for (int o = 32; o >= 1; o >>= 1) ss += __shfl_xor(ss, o);
    float rinv = rsqrtf(ss * (1.f / DM) + EPS);
#pragma unroll
    for (int i = 0; i < 4; ++i) {
      float4 gg = ((const float4*)g)[i * 64 + lane];
      uint2 o; o.x = pk2(v[i].x * rinv * gg.x, v[i].y * rinv * gg.y); o.y = pk2(v[i].z * rinv * gg.z, v[i].w * rinv * gg.w);
      *(uint2*)(H + (size_t)row * DM + (i * 64 + lane) * 4) = o;
    }
  }
}

#define RAW_BARRIER() do { asm volatile("s_waitcnt lgkmcnt(0)" ::: "memory"); __builtin_amdgcn_s_barrier(); } while (0)
DI void glds16(const bf16_t* g, char* l) {
  unsigned keep;
  const unsigned dst = __builtin_amdgcn_readfirstlane((unsigned)(size_t)l);
  asm volatile("s_mov_b32 %0, m0\n\ts_mov_b32 m0, %2\n\ts_nop 0\n\tglobal_load_lds_dwordx4 %1, off\n\ts_mov_b32 m0, %0"
               : "=&s"(keep) : "v"(g), "s"(dst) : "memory");
}
template <int MT>
DI void gemm_slice(char* __restrict__ dst, const char* __restrict__ src, bool issue, const bf16_t* const (&gA)[MT],
                   const bf16_t* const (&gB)[2], int ko, int wbA, int wbB, int offA, int offB, int hh, int sw,
                   f32x16 (&acc)[MT][2]) {
  bf16x8 fa[2][MT], fb[2][2];
#pragma unroll
  for (int s = 0; s < 2; ++s) {
    const int pc = ((2 * s + hh) ^ sw) * 16;
    fb[s][0] = *(const bf16x8*)(src + offB + pc);
    fb[s][1] = *(const bf16x8*)(src + offB + 2048 + pc);
#pragma unroll
    for (int mt = 0; mt < MT; ++mt) fa[s][mt] = *(const bf16x8*)(src + offA + mt * 2048 + pc);
  }
  __builtin_amdgcn_sched_barrier(0);
  if (issue) {
#pragma unroll
    for (int i = 0; i < MT; ++i) glds16(gA[i] + ko, dst + wbA + i * 1024);
#pragma unroll
    for (int i = 0; i < 2; ++i) glds16(gB[i] + ko, dst + wbB + i * 1024);
  }
  __builtin_amdgcn_sched_barrier(0);
#pragma unroll
  for (int s = 0; s < 2; ++s)
#pragma unroll
    for (int mt = 0; mt < MT; ++mt) {
      acc[mt][0] = MFMA32(fa[s][mt], fb[s][0], acc[mt][0]);
      acc[mt][1] = MFMA32(fa[s][mt], fb[s][1], acc[mt][1]);
    }
}

template <int NST, int MT>
DI void gemm_nt(const bf16_t* __restrict__ A, int lda, int rowmax, const bf16_t* __restrict__ B, int ldb, int K,
                f32x16 (&acc)[MT][2], char* smem) {
  constexpr int ABYTES = MT * 4096, STAGE = ABYTES + 8192;
  const int tid = tidx(), lane = tid & 63, wave = tid >> 6, r = lane & 31, hh = lane >> 5, wm = wave >> 1, wn = wave & 1;
  const bf16_t* gA[MT]; const bf16_t* gB[2];
#pragma unroll
  for (int i = 0; i < MT; ++i) {
    const int rl = (wave * MT + i) * 16 + (lane >> 2);
    const int c = (lane & 3) ^ ((rl >> 2) & 3);
    const int ar = rl < rowmax ? rl : rowmax;
    gA[i] = A + (size_t)ar * lda + c * 8;
  }
#pragma unroll
  for (int i = 0; i < 2; ++i) {
    const int rl = (wave * 2 + i) * 16 + (lane >> 2);
    const int c = (lane & 3) ^ ((rl >> 2) & 3);
    gB[i] = B + (size_t)rl * ldb + c * 8;
  }
  const int wv = __builtin_amdgcn_readfirstlane(wave);
  const int wbA = wv * (MT * 1024), wbB = ABYTES + wv * 2048;
  const int nk = K >> 5;
  const int sw = (r >> 2) & 3;
  const int offA = (wm * 32 * MT + r) * 64, offB = ABYTES + (wn * 64 + r) * 64;
  __syncthreads();
#pragma unroll
  for (int s = 0; s < NST - 1; ++s)
    if (s < nk) {
      char* sb = smem + s * STAGE;
#pragma unroll
      for (int i = 0; i < MT; ++i) glds16(gA[i] + s * 32, sb + wbA + i * 1024);
#pragma unroll
      for (int i = 0; i < 2; ++i) glds16(gB[i] + s * 32, sb + wbB + i * 1024);
    }
  constexpr int PER = MT + 2;
  for (int kt0 = 0; kt0 < nk; kt0 += NST) {
#pragma unroll
    for (int u = 0; u < NST; ++u) {
      const int kt = kt0 + u;
      if (kt < nk) {
        const int rem = nk - 1 - kt;
        if (NST >= 4 && rem >= 2) { if (PER == 4) asm volatile("s_waitcnt vmcnt(8)" ::: "memory"); else asm volatile("s_waitcnt vmcnt(12)" ::: "memory"); }
        else if (NST >= 3 && rem >= 1) { if (PER == 4) asm volatile("s_waitcnt vmcnt(4)" ::: "memory"); else asm volatile("s_waitcnt vmcnt(6)" ::: "memory"); }
        else asm volatile("s_waitcnt vmcnt(0)" ::: "memory");
        RAW_BARRIER();
        gemm_slice<MT>(smem + ((u + NST - 1) % NST) * STAGE, smem + u * STAGE, kt + NST - 1 < nk, gA, gB,
                       (kt + NST - 1) * 32, wbA, wbB, offA, offB, hh, sw, acc);
      }
    }
  }
}
template <int NST>
DI void gemm128_nt(const bf16_t* __restrict__ A, int lda, int rowmax, const bf16_t* __restrict__ B, int ldb, int K,
                   f32x16 (&acc)[2][2], char* smem) {
  gemm_nt<NST, 2>(A, lda, rowmax, B, ldb, K, acc, smem);
}

DI void store_row32(bf16_t* dst, const float (&v)[32]) {
#pragma unroll
  for (int q = 0; q < 4; ++q) {
    u32x4 u; u[0] = pk2(v[8 * q], v[8 * q + 1]); u[1] = pk2(v[8 * q + 2], v[8 * q + 3]);
    u[2] = pk2(v[8 * q + 4], v[8 * q + 5]); u[3] = pk2(v[8 * q + 6], v[8 * q + 7]);
    ((u32x4*)dst)[q] = u;
  }
}
DI void store_col32(bf16_t* dst, size_t stride, const float (&v)[32]) {
#pragma unroll
  for (int i = 0; i < 32; ++i) dst[(size_t)i * stride] = f2bf(v[i]);
}
DI void norm32(float (&v)[32], const float* gain, float scale) {
  float ss = 0.f;
#pragma unroll
  for (int i = 0; i < 32; ++i) ss += v[i] * v[i];
  ss += __shfl_xor(ss, 32);
  float rinv = rsqrtf(ss * (1.f / 64.f) + EPS) * scale;
#pragma unroll
  for (int i = 0; i < 32; ++i) v[i] = v[i] * rinv * gain[i];
}

DI void inproj_tile(const Params& p, int l, int rt, int ct, char* smem) {
  const int tid = tidx(), lane = tid & 63, wave = tid >> 6, r = lane & 31, hh = lane >> 5, wm = wave >> 1, wn = wave & 1;
  char* ws = p.ws;
  f32x16 acc[4][2];
#pragma unroll
  for (int a = 0; a < 4; ++a) for (int b = 0; b < 2; ++b) acc[a][b] = zero16();
  gemm_nt<3, 4>((const bf16_t*)(ws + OFF_H) + (size_t)rt * 256 * 1024, 1024, 255,
                (const bf16_t*)(ws + OFF_WIN + l * SZ_WIN_L) + (size_t)ct * 128 * 1024, 1024, 1024, acc, smem);
  __syncthreads();
  float* ep = (float*)smem + wave * (32 * 68);
  const int c = ct * 2 + wn;
#pragma unroll
  for (int mt = 0; mt < 4; ++mt) {
#pragma unroll
    for (int nt = 0; nt < 2; ++nt)
#pragma unroll
      for (int i = 0; i < 16; ++i) ep[crow(i, hh) * 68 + nt * 32 + r] = acc[mt][nt][i];
    __builtin_amdgcn_fence(__ATOMIC_RELEASE, "wavefront"); __builtin_amdgcn_wave_barrier(); __builtin_amdgcn_fence(__ATOMIC_ACQUIRE, "wavefront");
    float v[32];
#pragma unroll
    for (int q = 0; q < 8; ++q) {
      float4 f = *(const float4*)(ep + r * 68 + hh * 32 + q * 4);
      v[4 * q] = f.x; v[4 * q + 1] = f.y; v[4 * q + 2] = f.z; v[4 * q + 3] = f.w;
    }
    const int t = rt * 256 + wm * 128 + mt * 32 + r;
    const int b = t >> 13, s = t & (SEQ - 1);
    const int co = hh * 32;
    if (c < 8) {
      norm32(v, p.a_q_g + l * 64 + co, QSCALE);
      store_row32((bf16_t*)(ws + OFF_QA) + (size_t)t * 512 + c * 64 + co, v);
    } else if (c < 16) {
      norm32(v, p.a_k_g + l * 64 + co, 1.f);
      store_row32((bf16_t*)(ws + OFF_KA) + (size_t)t * 512 + (c - 8) * 64 + co, v);
    } else if (c < 24) {
      store_col32((bf16_t*)(ws + OFF_VAT) + ((size_t)b * 512 + (c - 16) * 64 + co) * SEQ + s, SEQ, v);
    } else if (c < 32) {
#pragma unroll
      for (int i = 0; i < 32; ++i) v[i] = siluf_(v[i]);
      store_row32((bf16_t*)(ws + OFF_GA) + (size_t)t * 512 + (c - 24) * 64 + co, v);
    } else if (c < 40) {
      norm32(v, p.b_q_g + l * 64 + co, QSCALE);
      store_row32((bf16_t*)(ws + OFF_QB) + (size_t)t * 512 + (c - 32) * 64 + co, v);
    } else if (c < 52) {
      const int sub = c - 40, br = sub >> 2, kv = (sub >> 1) & 1, g = sub & 1, bg = b * 2 + g;
      if (br == 0) {
        store_row32((bf16_t*)(ws + OFF_CKV) + ((size_t)(kv * 4 + bg) * SEQ + s) * 64 + co, v);
      } else if (kv == 0) {
        norm32(v, p.b_k_g + (l * 3 + br) * 64 + co, 1.f);
        store_row32((bf16_t*)(ws + (br == 1 ? OFF_KS : OFF_KW)) + ((size_t)bg * SEQ + s) * 64 + co, v);
      } else {
        store_col32((bf16_t*)(ws + (br == 1 ? OFF_VST : OFF_VWT)) + ((size_t)bg * 64 + co) * SEQ + s, SEQ, v);
      }
    } else if (c < 60) {
#pragma unroll
      for (int i = 0; i < 32; ++i) v[i] = siluf_(v[i]);
      store_row32((bf16_t*)(ws + OFF_GB) + (size_t)t * 512 + (c - 52) * 64 + co, v);
    } else if (c < 68) {
      store_row32((bf16_t*)(ws + OFF_CU) + (size_t)t * 512 + (c - 60) * 64 + co, v);
    } else if (c < 76) {
#pragma unroll
      for (int i = 0; i < 32; ++i) v[i] = siluf_(v[i]);
      store_row32((bf16_t*)(ws + OFF_GC) + (size_t)t * 512 + (c - 68) * 64 + co, v);
    } else if (c == 76) {
      if (hh == 0) {
#pragma unroll
        for (int i = 0; i < 32; ++i) v[i] = sigmoidf_(v[i]);
        store_row32((bf16_t*)(ws + OFF_BGT) + (size_t)t * 32, v);
      }
    }
    __builtin_amdgcn_fence(__ATOMIC_RELEASE, "wavefront"); __builtin_amdgcn_wave_barrier(); __builtin_amdgcn_fence(__ATOMIC_ACQUIRE, "wavefront");
  }
}

DI void diff_tile(const Params& p, int l, int b, int h, int qt, float lam, float lam_init, char* smem) {
  bf16_t* K1s = (bf16_t*)smem; bf16_t* K2s = K1s + 64 * 72; bf16_t* VTs = K2s + 64 * 72;
  const int tid = tidx(), lane = tid & 63, wave = tid >> 6, r = lane & 31, hh = lane >> 5;
  const int lr = tid >> 3, cc = tid & 7;
  const int m = wave >> 1, wq = wave & 1;
  char* ws = p.ws;
  const int q0 = qt * 64, qlo = q0 + 32 * wq, q = qlo + r;
  const bf16_t* KA = (const bf16_t*)(ws + OFF_KA) + (size_t)b * SEQ * 512 + h * 128;
  const bf16_t* VAT = (const bf16_t*)(ws + OFF_VAT) + ((size_t)b * 512 + h * 128) * SEQ;
  const bf16_t* Ks = m ? K2s : K1s;
  bf16x8 qf[4];
  {
    const bf16_t* qrow = (const bf16_t*)(ws + OFF_QA) + (size_t)(b * SEQ + q) * 512 + h * 128 + m * 64;
#pragma unroll
    for (int s = 0; s < 4; ++s) qf[s] = *(const bf16x8*)(qrow + s * 16 + hh * 8);
  }
  f32x16 O[4];
#pragma unroll
  for (int i = 0; i < 4; ++i) O[i] = zero16();
  float lsum = 0.f;
  const int nkt = qt + 1;
  u32x4 rk1[2], rk2[2], rv[4];
  auto issue_loads = [&](int k0) {
#pragma unroll
    for (int i = 0; i < 2; ++i) {
      const bf16_t* src = KA + (size_t)(k0 + lr + 32 * i) * 512 + cc * 8;
      rk1[i] = *(const u32x4*)src;
      rk2[i] = *(const u32x4*)(src + 64);
    }
#pragma unroll
    for (int i = 0; i < 4; ++i) rv[i] = *(const u32x4*)(VAT + (size_t)(lr + 32 * i) * SEQ + k0 + cc * 8);
  };
  issue_loads(0);
  for (int kt = 0; kt < nkt; ++kt) {
    const int k0 = kt * 64;
    __syncthreads();
#pragma unroll
    for (int i = 0; i < 2; ++i) {
      int row = lr + 32 * i;
      *(u32x4*)(K1s + row * 72 + cc * 8) = rk1[i];
      *(u32x4*)(K2s + row * 72 + cc * 8) = rk2[i];
    }
#pragma unroll
    for (int i = 0; i < 4; ++i) {
      int row = lr + 32 * i;
      bf16_t* d = VTs + row * 72 + (cc >> 1) * 16 + (cc & 1) * 4;
      *(uint2*)d = make_uint2(rv[i][0], rv[i][1]); *(uint2*)(d + 8) = make_uint2(rv[i][2], rv[i][3]);
    }
    __syncthreads();
    if (kt + 1 < nkt) issue_loads(k0 + 64);
    __builtin_amdgcn_sched_barrier(0);
    if (k0 + 63 <= qlo) {
      f32x16 sa = zero16(), sb = zero16();
#pragma unroll
      for (int s = 0; s < 4; ++s) {
        bf16x8 a1 = *(const bf16x8*)(Ks + r * 72 + s * 16 + hh * 8);
        bf16x8 a2 = *(const bf16x8*)(Ks + (32 + r) * 72 + s * 16 + hh * 8);
        sa = MFMA32(a1, qf[s], sa);
        sb = MFMA32(a2, qf[s], sb);
      }
      float la = 0.f, lb = 0.f;
#pragma unroll
      for (int i = 0; i < 16; ++i) { float pa = fast_exp2(sa[i]); sa[i] = pa; la += pa; }
#pragma unroll
      for (int sp = 0; sp < 2; ++sp) {
        bf16x8 pfa = pack8(sa, sp);
#pragma unroll
        for (int dt = 0; dt < 4; ++dt) {
          bf16x8 va = *(const bf16x8*)(VTs + (32 * dt + r) * 72 + 16 * sp + 8 * hh);
          O[dt] = MFMA32(va, pfa, O[dt]);
          const int j = 2 * (sp * 4 + dt);
          float p0 = fast_exp2(sb[j]), p1 = fast_exp2(sb[j + 1]);
          sb[j] = p0; sb[j + 1] = p1; lb += p0 + p1;
        }
      }
      lsum += la + lb;
#pragma unroll
      for (int sp = 0; sp < 2; ++sp) {
        bf16x8 pfb = pack8(sb, sp);
#pragma unroll
        for (int dt = 0; dt < 4; ++dt) {
          bf16x8 vb = *(const bf16x8*)(VTs + (32 * dt + r) * 72 + 32 + 16 * sp + 8 * hh);
          O[dt] = MFMA32(vb, pfb, O[dt]);
        }
      }
    } else
#pragma unroll
    for (int ks = 0; ks < 2; ++ks) {
      const int kb = k0 + 32 * ks;
      if (kb <= qlo + 31) {
        f32x16 s1 = zero16();
#pragma unroll
        for (int s = 0; s < 4; ++s) {
          bf16x8 a1 = *(const bf16x8*)(Ks + (32 * ks + r) * 72 + s * 16 + hh * 8);
          s1 = MFMA32(a1, qf[s], s1);
        }
        if (kb + 31 > qlo) {
#pragma unroll
          for (int i = 0; i < 16; ++i) {
            float p1 = (kb + crow(i, hh) <= q) ? fast_exp2(s1[i]) : 0.f;
            s1[i] = p1; lsum += p1;
          }
        } else {
          float la = 0.f, lb = 0.f;
#pragma unroll
          for (int i = 0; i < 16; i += 2) {
            float p1 = fast_exp2(s1[i]), p2 = fast_exp2(s1[i + 1]);
            s1[i] = p1; s1[i + 1] = p2; la += p1; lb += p2;
          }
          lsum += la + lb;
        }
#pragma unroll
        for (int sp = 0; sp < 2; ++sp) {
          bf16x8 pf1 = pack8(s1, sp);
#pragma unroll
          for (int dt = 0; dt < 4; ++dt) {
            bf16x8 vf = *(const bf16x8*)(VTs + (32 * dt + r) * 72 + 32 * ks + 16 * sp + 8 * hh);
            O[dt] = MFMA32(vf, pf1, O[dt]);
          }
        }
      }
    }
  }
  lsum += __shfl_xor(lsum, 32);
  const float sc = m == 0 ? 1.f / lsum : lam / lsum;
  __syncthreads();
  float* ex = (float*)smem + wq * 4096 + lane;
  if (m == 1) {
#pragma unroll
    for (int dt = 0; dt < 4; ++dt)
#pragma unroll
      for (int i = 0; i < 16; ++i) ex[(dt * 16 + i) * 64] = O[dt][i] * sc;
  }
  __syncthreads();
  if (m == 0) {
    float ss = 0.f;
#pragma unroll
    for (int dt = 0; dt < 4; ++dt)
#pragma unroll
      for (int i = 0; i < 16; ++i) { float o = O[dt][i] * sc - ex[(dt * 16 + i) * 64]; O[dt][i] = o; ss += o * o; }
    ss += __shfl_xor(ss, 32);
    const float rinv = rsqrtf(ss * (1.f / 128.f) + EPS) * (1.f - lam_init);
    bf16_t* ga = (bf16_t*)(ws + OFF_GA) + (size_t)(b * SEQ + q) * 512 + h * 128;
    const float* sg = p.a_subln_g + l * 128;
#pragma unroll
    for (int dt = 0; dt < 4; ++dt)
#pragma unroll
      for (int ig = 0; ig < 4; ++ig) {
        const int dv = 32 * dt + 8 * ig + 4 * hh;
        uint2 gate = *(const uint2*)(ga + dv);
        float4 g4 = *(const float4*)(sg + dv);
        float y0 = O[dt][4 * ig + 0] * rinv * g4.x * bflo(gate.x);
        float y1 = O[dt][4 * ig + 1] * rinv * g4.y * bfhi(gate.x);
        float y2 = O[dt][4 * ig + 2] * rinv * g4.z * bflo(gate.y);
        float y3 = O[dt][4 * ig + 3] * rinv * g4.w * bfhi(gate.y);
        *(uint2*)(ga + dv) = make_uint2(pk2(y0, y1), pk2(y2, y3));
      }
  }
}

DI void compress_tile(const Params& p, int l, int idx, char* smem) {
  bf16_t* Hs = (bf16_t*)(smem + 36864);
  const int tid = tidx(), lane = tid & 63, wave = tid >> 6, r = lane & 31, hh = lane >> 5, wm = wave >> 1, wn = wave & 1;
  char* ws = p.ws;
  const int j = idx & 1, rt = (idx >> 1) & 3, bg = idx >> 3;
  const bf16_t* A = (const bf16_t*)(ws + OFF_CKV) + (size_t)(j * 4 + bg) * SEQ * 64 + (size_t)rt * 128 * 1024;
  const int rowmax = 510 - rt * 128;
  const float* bias = (const float*)(ws + OFF_B1) + (l * 2 + j) * 256;
  const bf16_t* W1 = (const bf16_t*)(ws + OFF_W1 + l * SZ_W1_L) + (size_t)j * 256 * 2048;
  const bf16_t* W2 = (const bf16_t*)(ws + OFF_W2 + l * SZ_W2_L) + (size_t)j * 64 * 256;
  f32x16 acc2[2]; acc2[0] = zero16(); acc2[1] = zero16();
  for (int half = 0; half < 2; ++half) {
    f32x16 acc[2][2];
#pragma unroll
    for (int a = 0; a < 2; ++a) for (int b = 0; b < 2; ++b) acc[a][b] = zero16();
    gemm128_nt<2>(A, 1024, rowmax < 127 ? rowmax : 127, W1 + (size_t)half * 128 * 2048, 2048, 2048, acc, smem);
#pragma unroll
    for (int mt = 0; mt < 2; ++mt)
#pragma unroll
      for (int nt = 0; nt < 2; ++nt) {
        const int col = wn * 64 + nt * 32 + r;
        const float bv = bias[half * 128 + col];
#pragma unroll
        for (int i = 0; i < 16; ++i) {
          const int row = wm * 64 + mt * 32 + crow(i, hh);
          Hs[row * 136 + col] = f2bf(siluf_(acc[mt][nt][i] + bv));
        }
      }
    __syncthreads();
#pragma unroll
    for (int s = 0; s < 8; ++s) {
      bf16x8 a = *(const bf16x8*)(Hs + (32 * wave + r) * 136 + 16 * s + 8 * hh);
#pragma unroll
      for (int nt = 0; nt < 2; ++nt) {
        bf16x8 bb = *(const bf16x8*)(W2 + (size_t)(32 * nt + r) * 256 + half * 128 + 16 * s + 8 * hh);
        acc2[nt] = MFMA32(a, bb, acc2[nt]);
      }
    }
    __syncthreads();
  }
  if (j == 0) {
    bf16_t* KC = (bf16_t*)(ws + OFF_KC) + (size_t)bg * 512 * 64;
    const float g0 = p.b_k_g[(l * 3 + 0) * 64 + r], g1 = p.b_k_g[(l * 3 + 0) * 64 + 32 + r];
#pragma unroll
    for (int i = 0; i < 16; ++i) {
      float ss = acc2[0][i] * acc2[0][i] + acc2[1][i] * acc2[1][i];
#pragma unroll
      for (int o = 16; o >= 1; o >>= 1) ss += __shfl_xor(ss, o);
      float rinv = rsqrtf(ss * (1.f / 64.f) + EPS);
      const int n = rt * 128 + 32 * wave + crow(i, hh);
      const bool valid = n <= 510;
      KC[(size_t)n * 64 + r] = valid ? f2bf(acc2[0][i] * rinv * g0) : (bf16_t)0;
      KC[(size_t)n * 64 + 32 + r] = valid ? f2bf(acc2[1][i] * rinv * g1) : (bf16_t)0;
    }
  } else {
    bf16_t* VCT = (bf16_t*)(ws + OFF_VCT) + (size_t)bg * 64 * 512;
#pragma unroll
    for (int nt = 0; nt < 2; ++nt)
#pragma unroll
      for (int ig = 0; ig < 4; ++ig) {
        const int n = rt * 128 + 32 * wave + 8 * ig + 4 * hh;
        float v0 = acc2[nt][4 * ig], v1 = acc2[nt][4 * ig + 1], v2 = acc2[nt][4 * ig + 2], v3 = acc2[nt][4 * ig + 3];
        if (n + 3 > 510) v3 = 0.f;
        *(uint2*)(VCT + (size_t)(32 * nt + r) * 512 + n) = make_uint2(pk2(v0, v1), pk2(v2, v3));
      }
  }
}

DI void pool_tile(const Params& p, int l, int rt, int grp, char* smem) {
  bf16_t* Us = (bf16_t*)smem; bf16_t* Ps = Us + 144 * 136;
  const int tid = tidx(), lane = tid & 63, wave = tid >> 6, r = lane & 31, hh = lane >> 5;
  char* ws = p.ws;
  const int t0 = rt * 128, sq0 = t0 & (SEQ - 1);
  const bf16_t* CU = (const bf16_t*)(ws + OFF_CU);
  __syncthreads();
#pragma unroll
  for (int i = 0; i < 9; ++i) {
    int id = tid + 256 * i, row = id >> 4, c16 = id & 15;
    u32x4 v = {0u, 0u, 0u, 0u};
    if (sq0 - 16 + row >= 0) v = *(const u32x4*)(CU + (size_t)(t0 - 16 + row) * 512 + grp * 128 + c16 * 8);
    *(u32x4*)(Us + row * 136 + c16 * 8) = v;
  }
  __syncthreads();
  {
    const int w = 2 << grp, c = tid & 127, rh = tid >> 7;
    float sum = 0.f;
    for (int i = 0; i < w; ++i) sum += bf2f(Us[(rh * 64 + 16 - i) * 136 + c]);
    for (int lrow = rh * 64; lrow < rh * 64 + 64; ++lrow) {
      float cur = bf2f(Us[(lrow + 16) * 136 + c]);
      if (lrow != rh * 64) sum += cur - bf2f(Us[(lrow + 16 - w) * 136 + c]);
      int cnt = sq0 + lrow + 1; cnt = cnt < w ? cnt : w;
      Ps[lrow * 136 + c] = f2bf(sum / (float)cnt - cur);
    }
  }
  __syncthreads();
  f32x16 acc[4];
#pragma unroll
  for (int i = 0; i < 4; ++i) acc[i] = zero16();
  const bf16_t* CW = (const bf16_t*)(ws + OFF_CW + l * SZ_CW_L) + (size_t)grp * 128 * 128;
#pragma unroll
  for (int s = 0; s < 8; ++s) {
    bf16x8 a = *(const bf16x8*)(Ps + (32 * wave + r) * 136 + 16 * s + 8 * hh);
#pragma unroll
    for (int nt = 0; nt < 4; ++nt) {
      bf16x8 bb = *(const bf16x8*)(CW + (size_t)(32 * nt + r) * 128 + 16 * s + 8 * hh);
      acc[nt] = MFMA32(a, bb, acc[nt]);
    }
  }
  bf16_t* GC = (bf16_t*)(ws + OFF_GC);
#pragma unroll
  for (int nt = 0; nt < 4; ++nt) {
    const int col = grp * 128 + 32 * nt + r;
    const float sc = p.c_scale[l * 512 + col];
#pragma unroll
    for (int i = 0; i < 16; ++i) {
      const size_t idx = (size_t)(t0 + 32 * wave + crow(i, hh)) * 512 + col;
      GC[idx] = f2bf(acc[nt][i] * sc * bf2f(GC[idx]));
    }
  }
}

DI void nsa_load_kv(bf16_t* Ks, bf16_t* VTs, const bf16_t* ksrc  ,
                    const bf16_t* vsrc  , size_t ldv, bool loadv) {
  const int tid = tidx(), lr = tid >> 3, cc = tid & 7;
#pragma unroll
  for (int i = 0; i < 2; ++i) {
    int row = lr + 32 * i;
    *(u32x4*)(Ks + row * 72 + cc * 8) = *(const u32x4*)(ksrc + (size_t)row * 64 + cc * 8);
    if (loadv) {
      u32x4 v = *(const u32x4*)(vsrc + (size_t)row * ldv + cc * 8);
      bf16_t* d = VTs + row * 72 + (cc >> 1) * 16 + (cc & 1) * 4;
      *(uint2*)d = make_uint2(v[0], v[1]); *(uint2*)(d + 8) = make_uint2(v[2], v[3]);
    }
  }
}
DI void nsa_load_kv2(bf16_t* Ks, bf16_t* VTs, const bf16_t* k0, const bf16_t* v0, const bf16_t* k1, const bf16_t* v1, size_t ldv) {
  const int tid = tidx(), lr = tid >> 3, cc = tid & 7;
  u32x4 rk[4], rv[4];
#pragma unroll
  for (int i = 0; i < 2; ++i) {
    const int row = lr + 32 * i;
    rk[i] = *(const u32x4*)(k0 + (size_t)row * 64 + cc * 8);
    rk[2 + i] = *(const u32x4*)(k1 + (size_t)row * 64 + cc * 8);
    rv[i] = *(const u32x4*)(v0 + (size_t)row * ldv + cc * 8);
    rv[2 + i] = *(const u32x4*)(v1 + (size_t)row * ldv + cc * 8);
  }
  __builtin_amdgcn_sched_barrier(0);
#pragma unroll
  for (int i = 0; i < 2; ++i) {
    const int row = lr + 32 * i;
    *(u32x4*)(Ks + row * 72 + cc * 8) = rk[i];
    *(u32x4*)(Ks + 64 * 72 + row * 72 + cc * 8) = rk[2 + i];
    bf16_t* d0 = VTs + row * 72 + (cc >> 1) * 16 + (cc & 1) * 4;
    *(uint2*)d0 = make_uint2(rv[i][0], rv[i][1]); *(uint2*)(d0 + 8) = make_uint2(rv[i][2], rv[i][3]);
    bf16_t* d1 = d0 + 64 * 72;
    *(uint2*)d1 = make_uint2(rv[2 + i][0], rv[2 + i][1]); *(uint2*)(d1 + 8) = make_uint2(rv[2 + i][2], rv[2 + i][3]);
  }
}
DI f32x16 nsa_scores(const bf16_t* Ks, int ks, int r, int hh, const bf16x8 (&qf)[4], float init = 0.f) {
  f32x16 s;
#pragma unroll
  for (int i = 0; i < 16; ++i) s[i] = init;
#pragma unroll
  for (int k = 0; k < 4; ++k) {
    bf16x8 a = *(const bf16x8*)(Ks + (32 * ks + r) * 72 + k * 16 + hh * 8);
    s = MFMA32(a, qf[k], s);
  }
  return s;
}
DI void nsa_pv(const bf16_t* VTs, int ks, int r, int hh, const f32x16& pr, f32x16 (&o)[2]) {
#pragma unroll
  for (int sp = 0; sp < 2; ++sp) {
    bf16x8 pf = pack8(pr, sp);
#pragma unroll
    for (int dt = 0; dt < 2; ++dt) {
      bf16x8 vf = *(const bf16x8*)(VTs + (32 * dt + r) * 72 + 32 * ks + 16 * sp + 8 * hh);
      o[dt] = MFMA32(vf, pf, o[dt]);
    }
  }
}

DI void nsa_tile64_fast(const bf16_t* Ks, const bf16_t* VTs, int r, int hh, const bf16x8 (&qf)[4], float init,
                        f32x16 (&o)[2], float& lsum) {
  f32x16 sa, sb;
#pragma unroll
  for (int i = 0; i < 16; ++i) { sa[i] = init; sb[i] = init; }
#pragma unroll
  for (int k = 0; k < 4; ++k) {
    bf16x8 a1 = *(const bf16x8*)(Ks + r * 72 + k * 16 + hh * 8);
    bf16x8 a2 = *(const bf16x8*)(Ks + (32 + r) * 72 + k * 16 + hh * 8);
    sa = MFMA32(a1, qf[k], sa);
    sb = MFMA32(a2, qf[k], sb);
  }
  float la = 0.f, lb = 0.f;
#pragma unroll
  for (int i = 0; i < 16; ++i) { float pa = fast_exp2(sa[i]); sa[i] = pa; la += pa; }
#pragma unroll
  for (int i = 0; i < 16; ++i) { float pb = fast_exp2(sb[i]); sb[i] = pb; lb += pb; }
  lsum += la + lb;
#pragma unroll
  for (int sp = 0; sp < 2; ++sp) {
    bf16x8 pfa = pack8(sa, sp), pfb = pack8(sb, sp);
#pragma unroll
    for (int dt = 0; dt < 2; ++dt) {
      bf16x8 va = *(const bf16x8*)(VTs + (32 * dt + r) * 72 + 16 * sp + 8 * hh);
      bf16x8 vb = *(const bf16x8*)(VTs + (32 * dt + r) * 72 + 32 + 16 * sp + 8 * hh);
      o[dt] = MFMA32(va, pfa, o[dt]);
      o[dt] = MFMA32(vb, pfb, o[dt]);
    }
  }
}

DI void nsa_tile(const Params& p, int l, int bg, int qt, char* smem) {
  bf16_t* Ks = (bf16_t*)smem; bf16_t* VTs = Ks + 2 * 64 * 72;
  float* impm = (float*)(smem + 36864); float* impt = impm + 32 * 132;
  const int tid = tidx(), lane = tid & 63, wave = tid >> 6, r = lane & 31, hh = lane >> 5;
  char* ws = p.ws;
  const int b = bg >> 1, g = bg & 1;
  const int q0 = qt * 32, cur = q0 >> 6, ql = 8 * wave + (r & 7), q = q0 + ql, hd = r >> 3;
  const size_t tok = (size_t)b * SEQ + q;
  bf16x8 qf[4];
  {
    const bf16_t* qrow = (const bf16_t*)(ws + OFF_QB) + tok * 512 + g * 256 + hd * 64;
#pragma unroll
    for (int s = 0; s < 4; ++s) qf[s] = *(const bf16x8*)(qrow + s * 16 + hh * 8);
  }
  float gc, gs, gw;
  {
    const bf16_t* gp = (const bf16_t*)(ws + OFF_BGT) + tok * 32 + g * 12 + hd * 3;
    gc = bf2f(gp[0]); gs = bf2f(gp[1]); gw = bf2f(gp[2]);
  }
  __syncthreads();
  for (int i = tid; i < 2 * 32 * 132; i += 256) impm[i] = 0.f;
  const int ncb = 2 * qt + 1, nct = (ncb + 63) >> 6;
  const bf16_t* KCb = (const bf16_t*)(ws + OFF_KC) + (size_t)bg * 512 * 64;
  const bf16_t* VCTb = (const bf16_t*)(ws + OFF_VCT) + (size_t)bg * 64 * 512;
  float lc = 0.f;
  for (int kt = 0; kt < nct; ++kt) {
    const int n0 = kt * 64;
    __syncthreads();
    nsa_load_kv(Ks, VTs, KCb + (size_t)n0 * 64, VCTb + n0, 512, false);
    __syncthreads();
#pragma unroll
    for (int ks = 0; ks < 2; ++ks)
      if (n0 + 32 * ks < ncb) {
        f32x16 s = nsa_scores(Ks, ks, r, hh, qf);
#pragma unroll
        for (int i = 0; i < 16; ++i) {
          int n = n0 + 32 * ks + crow(i, hh);
          lc += (16 * n + 31 <= q) ? fast_exp2(s[i]) : 0.f;
        }
      }
  }
  lc += __shfl_xor(lc, 32);
  const float linv = lc > 0.f ? 1.f / lc : 0.f;
  f32x16 fin[2], oc[2];
  oc[0] = zero16(); oc[1] = zero16();
  for (int kt = 0; kt < nct; ++kt) {
    const int n0 = kt * 64;
    __syncthreads();
    nsa_load_kv(Ks, VTs, KCb + (size_t)n0 * 64, VCTb + n0, 512, true);
    __syncthreads();
#pragma unroll
    for (int ks = 0; ks < 2; ++ks)
      if (n0 + 32 * ks < ncb) {
        f32x16 s = nsa_scores(Ks, ks, r, hh, qf);
#pragma unroll
        for (int i = 0; i < 16; ++i) {
          int n = n0 + 32 * ks + crow(i, hh);
          s[i] = (16 * n + 31 <= q) ? fast_exp2(s[i]) * linv : 0.f;
        }
#pragma unroll
        for (int ig = 0; ig < 4; ++ig) {
          float tl = 0.5f * s[4 * ig + 3];
          float mn = s[4 * ig] + s[4 * ig + 1] + s[4 * ig + 2] + tl;
          mn += __shfl_xor(mn, 8); mn += __shfl_xor(mn, 16);
          tl += __shfl_xor(tl, 8); tl += __shfl_xor(tl, 16);
          if (hd == 0) {
            int sidx = (n0 >> 2) + 8 * ks + 2 * ig + hh;
            impm[ql * 132 + sidx] = mn;
            impt[ql * 132 + sidx + 1] = tl;
          }
        }
        nsa_pv(VTs, ks, r, hh, s, oc);
      }
  }
#pragma unroll
  for (int dt = 0; dt < 2; ++dt)
#pragma unroll
    for (int i = 0; i < 16; ++i) fin[dt][i] = gc * oc[dt][i];
  __syncthreads();
  unsigned long long mylo = 0ull, myhi = 0ull;
  if (cur <= 15) {
    mylo = (2ull << cur) - 1ull;
  } else {
    for (int qi = 0; qi < 8; ++qi) {
      const float* im = impm + (8 * wave + qi) * 132; const float* it = impt + (8 * wave + qi) * 132;
      const int s0 = lane, s1 = lane + 64;
      float v0 = im[s0] + it[s0], v1 = im[s1] + it[s1];
      unsigned k0 = (s0 >= 1 && s0 <= cur - 2) ? __float_as_uint(v0) + 1u : 0u;
      unsigned k1 = (s1 <= cur - 2) ? __float_as_uint(v1) + 1u : 0u;
      unsigned T = 0u;
      for (int bit = 31; bit >= 0; --bit) {
        unsigned cand = T | (1u << bit);
        int cnt = __popcll(__ballot(k0 >= cand)) + __popcll(__ballot(k1 >= cand));
        if (cnt >= 13) T = cand;
      }
      unsigned long long g0 = __ballot(k0 > T), g1 = __ballot(k1 > T);
      unsigned long long e0 = __ballot(k0 == T), e1 = __ballot(k1 == T);
      int need = 13 - __popcll(g0) - __popcll(g1);
      while (need > 0 && e0) { unsigned long long lb = e0 & (~e0 + 1ull); g0 |= lb; e0 ^= lb; --need; }
      while (need > 0 && e1) { unsigned long long lb = e1 & (~e1 + 1ull); g1 |= lb; e1 ^= lb; --need; }
      g0 |= 1ull;
      if (cur - 1 < 64) g0 |= 1ull << (cur - 1); else g1 |= 1ull << (cur - 1 - 64);
      if (cur < 64) g0 |= 1ull << cur; else g1 |= 1ull << (cur - 64);
      if ((r & 7) == qi) { mylo = g0; myhi = g1; }
    }
  }
  {
    f32x16 os[2]; os[0] = zero16(); os[1] = zero16();
    float ls = 0.f;
    const bf16_t* KSb = (const bf16_t*)(ws + OFF_KS) + (size_t)bg * SEQ * 64;
    const bf16_t* VSTb = (const bf16_t*)(ws + OFF_VST) + (size_t)bg * 64 * SEQ;
    auto slc_compute = [&](int j, const bf16_t* KsP, const bf16_t* VTsP) {
      const bool mysel = (j < 64 ? (mylo >> j) : (myhi >> (j - 64))) & 1ull;
      if (__ballot(mysel) != 0ull) {
        if (j < cur) nsa_tile64_fast(KsP, VTsP, r, hh, qf, mysel ? 0.f : -1e30f, os, ls);
        else
#pragma unroll
        for (int ks = 0; ks < 2; ++ks) {
          const int kb = j * 64 + 32 * ks;
          if (kb <= q0 + 31) {
            f32x16 s = nsa_scores(KsP, ks, r, hh, qf, mysel ? 0.f : -1e30f);
            if (j == cur) {
#pragma unroll
              for (int i = 0; i < 16; ++i) {
                float pv = (kb + crow(i, hh) <= q) ? fast_exp2(s[i]) : 0.f;
                s[i] = pv; ls += pv;
              }
            } else {
              float la = 0.f, lb = 0.f;
#pragma unroll
              for (int i = 0; i < 16; i += 2) {
                float p1 = fast_exp2(s[i]), p2 = fast_exp2(s[i + 1]);
                s[i] = p1; s[i + 1] = p2; la += p1; lb += p2;
              }
              ls += la + lb;
            }
            nsa_pv(VTsP, ks, r, hh, s, os);
          }
        }
      }
    };
    u32x4 prk[4], prv[4];
    const int plr = tid >> 3, pcc = tid & 7;
    auto slc_issue = [&](int j) {
      const int j1 = (j + 1 <= cur) ? j + 1 : j;
#pragma unroll
      for (int i = 0; i < 2; ++i) {
        const int row = plr + 32 * i;
        prk[i] = *(const u32x4*)(KSb + ((size_t)j * 64 + row) * 64 + pcc * 8);
        prk[2 + i] = *(const u32x4*)(KSb + ((size_t)j1 * 64 + row) * 64 + pcc * 8);
        prv[i] = *(const u32x4*)(VSTb + (size_t)row * SEQ + j * 64 + pcc * 8);
        prv[2 + i] = *(const u32x4*)(VSTb + (size_t)row * SEQ + j1 * 64 + pcc * 8);
      }
    };
    slc_issue(0);
    for (int j = 0; j <= cur; j += 2) {
      const bool two = (j + 1 <= cur);
      __syncthreads();
#pragma unroll
      for (int i = 0; i < 2; ++i) {
        const int row = plr + 32 * i;
        *(u32x4*)(Ks + row * 72 + pcc * 8) = prk[i];
        *(u32x4*)(Ks + 64 * 72 + row * 72 + pcc * 8) = prk[2 + i];
        bf16_t* d0 = VTs + row * 72 + (pcc >> 1) * 16 + (pcc & 1) * 4;
        *(uint2*)d0 = make_uint2(prv[i][0], prv[i][1]); *(uint2*)(d0 + 8) = make_uint2(prv[i][2], prv[i][3]);
        bf16_t* d1 = d0 + 64 * 72;
        *(uint2*)d1 = make_uint2(prv[2 + i][0], prv[2 + i][1]); *(uint2*)(d1 + 8) = make_uint2(prv[2 + i][2], prv[2 + i][3]);
      }
      __syncthreads();
      if (j + 2 <= cur) slc_issue(j + 2);
      __builtin_amdgcn_sched_barrier(0);
      slc_compute(j, Ks, VTs);
      if (two) slc_compute(j + 1, Ks + 64 * 72, VTs + 64 * 72);
    }
    ls += __shfl_xor(ls, 32);
    const float cs = gs / ls;
#pragma unroll
    for (int dt = 0; dt < 2; ++dt)
#pragma unroll
      for (int i = 0; i < 16; ++i) fin[dt][i] += cs * os[dt][i];
  }
  {
    f32x16 ow[2]; ow[0] = zero16(); ow[1] = zero16();
    float lw = 0.f;
    const bf16_t* KWb = (const bf16_t*)(ws + OFF_KW) + (size_t)bg * SEQ * 64;
    const bf16_t* VWTb = (const bf16_t*)(ws + OFF_VWT) + (size_t)bg * 64 * SEQ;
    const int lo = q0 - 511;
    const int kt_lo = (lo > 0 ? lo : 0) >> 6;
    auto win_compute = [&](int kt, const bf16_t* KsP, const bf16_t* VTsP) {
      const int qw0f = q0 + 8 * wave;
      if (kt * 64 + 63 <= qw0f && kt * 64 > qw0f + 7 - 512) { nsa_tile64_fast(KsP, VTsP, r, hh, qf, 0.f, ow, lw); return; }
#pragma unroll
      for (int ks = 0; ks < 2; ++ks) {
        const int kb = kt * 64 + 32 * ks;
        if (kb <= q0 + 31 && kb + 31 > q0 - 512) {
          f32x16 s = nsa_scores(KsP, ks, r, hh, qf);
          const int qw0 = q0 + 8 * wave;
          if (kb + 31 <= qw0 && kb > qw0 + 7 - 512) {
            float la = 0.f, lb = 0.f;
#pragma unroll
            for (int i = 0; i < 16; i += 2) {
              float p1 = fast_exp2(s[i]), p2 = fast_exp2(s[i + 1]);
              s[i] = p1; s[i + 1] = p2; la += p1; lb += p2;
            }
            lw += la + lb;
          } else {
#pragma unroll
            for (int i = 0; i < 16; ++i) {
              int key = kb + crow(i, hh);
              float pv = (key <= q && key > q - 512) ? fast_exp2(s[i]) : 0.f;
              s[i] = pv; lw += pv;
            }
          }
          nsa_pv(VTsP, ks, r, hh, s, ow);
        }
      }
    };
    for (int kt = kt_lo; kt <= cur; kt += 2) {
      const bool two = (kt + 1 <= cur);
      __syncthreads();
      const int kt1 = two ? kt + 1 : kt;
      nsa_load_kv2(Ks, VTs, KWb + (size_t)kt * 64 * 64, VWTb + kt * 64, KWb + (size_t)kt1 * 64 * 64, VWTb + kt1 * 64, SEQ);
      __syncthreads();
      win_compute(kt, Ks, VTs);
      if (two) win_compute(kt + 1, Ks + 64 * 72, VTs + 64 * 72);
    }
    lw += __shfl_xor(lw, 32);
    const float cw = gw / lw;
#pragma unroll
    for (int dt = 0; dt < 2; ++dt)
#pragma unroll
      for (int i = 0; i < 16; ++i) fin[dt][i] += cw * ow[dt][i];
  }
  bf16_t* gb = (bf16_t*)(ws + OFF_GB) + tok * 512 + g * 256 + hd * 64;
#pragma unroll
  for (int dt = 0; dt < 2; ++dt)
#pragma unroll
    for (int ig = 0; ig < 4; ++ig) {
      const int dv = 32 * dt + 8 * ig + 4 * hh;
      uint2 gate = *(const uint2*)(gb + dv);
      float y0 = fin[dt][4 * ig + 0] * bflo(gate.x), y1 = fin[dt][4 * ig + 1] * bfhi(gate.x);
      float y2 = fin[dt][4 * ig + 2] * bflo(gate.y), y3 = fin[dt][4 * ig + 3] * bfhi(gate.y);
      *(uint2*)(gb + dv) = make_uint2(pk2(y0, y1), pk2(y2, y3));
    }
}

DI void merge_tile(const Params& p, int l, int rt, int ct, char* smem) {
  const int tid = tidx(), lane = tid & 63, wave = tid >> 6, r = lane & 31, hh = lane >> 5, wm = wave >> 1, wn = wave & 1;
  char* ws = p.ws;
  f32x16 mg[2][2];
#pragma unroll
  for (int a = 0; a < 2; ++a) for (int b = 0; b < 2; ++b) mg[a][b] = zero16();
  const bf16_t* H = (const bf16_t*)(ws + OFF_H) + (size_t)rt * 128 * 1024;
  const bf16_t* WIN = (const bf16_t*)(ws + OFF_WIN + l * SZ_WIN_L) + (size_t)4992 * 1024;
  const bf16_t* WB = (const bf16_t*)(ws + OFF_WB + l * SZ_WB_L);
#pragma unroll 1
  for (int br = 0; br < 3; ++br) {
    unsigned gpk[2][2][8];
    {
      f32x16 acc[2][2];
#pragma unroll
      for (int a = 0; a < 2; ++a) for (int b = 0; b < 2; ++b) acc[a][b] = zero16();
      gemm128_nt<4>(H, 1024, 127, WIN + ((size_t)br * 1024 + ct * 128) * 1024, 1024, 1024, acc, smem);
#pragma unroll
      for (int a = 0; a < 2; ++a)
#pragma unroll
        for (int b = 0; b < 2; ++b)
#pragma unroll
          for (int i = 0; i < 8; ++i) gpk[a][b][i] = pk2(sigmoidf_(acc[a][b][2 * i]), sigmoidf_(acc[a][b][2 * i + 1]));
    }
    {
      f32x16 acc[2][2];
#pragma unroll
      for (int a = 0; a < 2; ++a) for (int b = 0; b < 2; ++b) acc[a][b] = zero16();
      const bf16_t* U = (const bf16_t*)(ws + (br == 0 ? OFF_GA : (br == 1 ? OFF_GB : OFF_GC))) + (size_t)rt * 128 * 512;
      gemm128_nt<4>(U, 512, 127, WB + ((size_t)br * 1024 + ct * 128) * 512, 512, 512, acc, smem);
#pragma unroll
      for (int a = 0; a < 2; ++a)
#pragma unroll
        for (int b = 0; b < 2; ++b)
#pragma unroll
          for (int i = 0; i < 8; ++i) {
            const unsigned gv = gpk[a][b][i];
            mg[a][b][2 * i] += bflo(gv) * acc[a][b][2 * i];
            mg[a][b][2 * i + 1] += bfhi(gv) * acc[a][b][2 * i + 1];
          }
    }
  }
  bf16_t* M = (bf16_t*)(ws + OFF_MERGED);
#pragma unroll
  for (int a = 0; a < 2; ++a)
#pragma unroll
    for (int b = 0; b < 2; ++b)
#pragma unroll
      for (int i = 0; i < 16; ++i) {
        const int row = rt * 128 + wm * 64 + a * 32 + crow(i, hh), col = ct * 128 + wn * 64 + b * 32 + r;
        M[(size_t)row * 1024 + col] = f2bf(mg[a][b][i]);
      }
}

DI void outproj_tile(const Params& p, int l, int rt, int ct, char* smem) {
  const int tid = tidx(), lane = tid & 63, wave = tid >> 6, r = lane & 31, hh = lane >> 5, wm = wave >> 1, wn = wave & 1;
  char* ws = p.ws;
  f32x16 acc[4][2];
#pragma unroll
  for (int a = 0; a < 4; ++a) for (int b = 0; b < 2; ++b) acc[a][b] = zero16();
  gemm_nt<3, 4>((const bf16_t*)(ws + OFF_MERGED) + (size_t)rt * 256 * 1024, 1024, 255,
                (const bf16_t*)(ws + OFF_WO + l * SZ_WO_L) + (size_t)ct * 128 * 1024, 1024, 1024, acc, smem);
  const float* xin = l == 0 ? p.x : p.out;
#pragma unroll
  for (int a = 0; a < 4; ++a)
#pragma unroll
    for (int b = 0; b < 2; ++b) {
      const size_t base = (size_t)(rt * 256 + wm * 128 + a * 32) * 1024 + ct * 128 + wn * 64 + b * 32 + r;
      float xv[16];
#pragma unroll
      for (int i = 0; i < 16; ++i) xv[i] = xin[base + (size_t)crow(i, hh) * 1024];
      __builtin_amdgcn_sched_barrier(0);
#pragma unroll
      for (int i = 0; i < 16; ++i) p.out[base + (size_t)crow(i, hh) * 1024] = xv[i] + acc[a][b][i];
    }
}

DI unsigned xb_ld(unsigned* p) { return __hip_atomic_load(p, __ATOMIC_RELAXED, __HIP_MEMORY_SCOPE_AGENT); }
DI unsigned xb_add(unsigned* p, unsigned v) { return __hip_atomic_fetch_add(p, v, __ATOMIC_RELAXED, __HIP_MEMORY_SCOPE_AGENT); }
DI void grid_barrier(unsigned* ctr, unsigned target) {
  asm volatile("s_waitcnt vmcnt(0)" ::: "memory");
  __syncthreads();
  if (tidx() == 0) {
    __builtin_amdgcn_fence(__ATOMIC_RELEASE, "agent");
    asm volatile("s_waitcnt vmcnt(0)" ::: "memory");
    xb_add(ctr, 1u);
    unsigned spins = 0;
    while (xb_ld(ctr) < target && spins < (1u << 22)) { __builtin_amdgcn_s_sleep(2); ++spins; }
    __builtin_amdgcn_fence(__ATOMIC_ACQUIRE, "agent");
    asm volatile("s_waitcnt vmcnt(0)" ::: "memory");
  }
  __syncthreads();
}

DI void xcd_barrier(unsigned* bar, unsigned xcc, const volatile int* xinfo, unsigned k) {
  asm volatile("s_waitcnt vmcnt(0)" ::: "memory");
  __syncthreads();
  if (tidx() == 0) {
    const unsigned nloc = (unsigned)xinfo[2], nx = (unsigned)xinfo[3];
    unsigned* xsub = bar + 512 + 64 * xcc; unsigned* xgen = bar + 1536 + 64 * xcc;
    unsigned* top = bar + 2560; unsigned* topgen = bar + 2624;
    const unsigned old = xb_add(xsub, 1u);
    unsigned spins = 0;
    if (old + 1u == k * nloc) {
      __builtin_amdgcn_fence(__ATOMIC_RELEASE, "agent");
      asm volatile("s_waitcnt vmcnt(0)" ::: "memory");
      const unsigned og = xb_add(top, 1u);
      if (og + 1u == k * nx) xb_add(topgen, 1u);
      else while (xb_ld(topgen) < k && spins < (1u << 22)) { __builtin_amdgcn_s_sleep(1); ++spins; }
      __builtin_amdgcn_fence(__ATOMIC_ACQUIRE, "agent");
      xb_add(xgen, 1u);
      asm volatile("s_waitcnt vmcnt(0)" ::: "memory");
    } else {
      while (xb_ld(xgen) < k && spins < (1u << 22)) { __builtin_amdgcn_s_sleep(1); ++spins; }
      __builtin_amdgcn_fence(__ATOMIC_ACQUIRE, "agent");
      asm volatile("s_waitcnt vmcnt(0)" ::: "memory");
    }
  }
  __syncthreads();
}

DI float wave_sum(float v) {
#pragma unroll
  for (int o = 32; o >= 1; o >>= 1) v += __shfl_xor(v, o);
  return v;
}

template <int PH>
DI void run_phase(const Params& p, int l, char* smem) {
  const int G = gridDim.x, bid = blockIdx.x;
  if (PH == 0) {
    const int nprep = l == 0 ? 2 * PREP_L : 0;
    for (int t = bid; t < nprep + 1024; t += G) {
      if (t < nprep) prep_tile(p, t, smem); else norm_tile(p, l, t - nprep);
    }
  } else if (PH == 1) {
    const int xcd = bid & 7, slot = bid >> 3, nslot = G >> 3;
    for (int st = xcd; st < 8 * 5; st += 8) {
      const int str = st & 7, stc = st >> 3;
      for (int s = slot; s < 64; s += nslot) {
        const int rt = str * 8 + (s & 7), ct = stc * 8 + (s >> 3);
        if (ct < 39) inproj_tile(p, l, rt, ct, smem);
      }
    }
  } else if (PH == 2) {
    const float lam_init = 0.8f - 0.6f * __expf(-0.3f * (float)l);
    const int lane = tidx() & 63;
    const float* lp = p.a_lam + l * 256;
    const float d1 = wave_sum(lp[lane] * lp[64 + lane]), d2 = wave_sum(lp[128 + lane] * lp[192 + lane]);
    const float lam = __expf(d1) - __expf(d2) + lam_init;
    if (G == 512) {
      const int bin = bid;
      unsigned long long ilo = 0ull, ihi = 0ull; int nit = 0;
      auto push = [&](int bh, int c) {
        const unsigned long long e = (unsigned long long)(bh | ((c - 1) << 3));
        if (nit < 6) ilo |= e << (10 * nit); else ihi |= e << (10 * (nit - 6));
        ++nit;
      };
      if (bin < 32) {
        push(bin & 7, 86 + (bin >> 3));
      } else if (bin < 344) {
        const int i = bin - 32; push(i & 7, 128 - (i >> 3)); push(i & 7, 4 + (i >> 3));
      } else if (bin < 496) {
        const int i = bin - 344; push(i & 7, 85 - (i >> 3)); push(i & 7, 47 + (i >> 3));
      } else if (bin < 500) {
        const int n = bin - 496; push(2 * n, 66); push(2 * n + 1, 66);
      } else {
        const int n = bin - 500;
        if (n < 8) {
          for (int k = 0; k < 3; ++k) { const int m = 3 * n + k; push(m >> 2, 43 + (m & 3)); }
        } else {
          for (int k = 0; k < 2; ++k) { const int m = 24 + 2 * (n - 8) + k; push(m >> 2, 43 + (m & 3)); }
          for (int k = 0; k < 6; ++k) { const int s = 6 * (n - 8) + k; push(s & 7, 1 + (s >> 3)); }
        }
      }
      for (int k = 0; k < nit; ++k) {
        const int e = (int)(((k < 6 ? ilo >> (10 * k) : ihi >> (10 * (k - 6)))) & 1023ull);
        diff_tile(p, l, (e & 7) >> 2, e & 3, e >> 3, lam, lam_init, smem);
      }
      if (bin < 32) compress_tile(p, l, bin, smem);
      pool_tile(p, l, bin >> 2, bin & 3, smem);
    } else {
      for (int t = bid; t < 512; t += G) {
        const int bh = t & 7, pp = (t >> 3) & 63;
        diff_tile(p, l, bh >> 2, bh & 3, 127 - pp, lam, lam_init, smem);
        diff_tile(p, l, bh >> 2, bh & 3, pp, lam, lam_init, smem);
      }
      const int b2 = (bid + G - (512 % G)) % G;
      for (int t = b2; t < 32; t += G) compress_tile(p, l, t, smem);
      const int b3 = (b2 + G - (32 % G)) % G;
      for (int u = b3; u < 512; u += G) pool_tile(p, l, u >> 2, u & 3, smem);
    }
  } else if (PH == 3) {
    int k = 0;
    for (int base = 0; base < 1024; base += G, ++k) {
      int t = (k & 1) ? base + (G - 1 - bid) : base + bid;
      if (t < 1024) {
        const int qt = 255 - (t >> 2), bg = t & 3;
        nsa_tile(p, l, bg, qt, smem);
      }
    }
  } else if (PH == 4) {
    const int xcd = bid & 7, slot = bid >> 3, nslot = G >> 3;
    for (int st = xcd; st < 16; st += 8) {
      for (int s = slot; s < 64; s += nslot) {
        const int rt = st * 8 + (s & 7), ct = s >> 3;
        merge_tile(p, l, rt, ct, smem);
      }
    }
  } else if (PH == 5) {
    const int xcd = bid & 7, slot = bid >> 3, nslot = G >> 3;
    for (int s = slot; s < 64; s += nslot) {
      const int rt = xcd * 8 + (s & 7), ct = s >> 3;
      outproj_tile(p, l, rt, ct, smem);
    }
  }
}

#if MK_ONE_LAUNCH
#define AS1 __attribute__((address_space(1)))
#define AS4 __attribute__((address_space(4)))
struct ParamsD {
  AS1 const float* x; AS1 const float* norm_g; AS1 const float* w_in; AS1 const float* a_q_g; AS1 const float* a_k_g; AS1 const float* a_lam;
  AS1 const float* a_subln_g; AS1 const float* b_q_g; AS1 const float* b_k_g; AS1 const float* b_cmp_pos; AS1 const float* b_phi_w1;
  AS1 const float* b_phi_w2; AS1 const float* c_w; AS1 const float* c_scale; AS1 const float* w_branch; AS1 const float* w_out;
  AS1 float* out; AS1 char* ws;
};
template <int PH>
DI void phase_opaque(int l, char* smem) {
  size_t z = 0;
  asm volatile("" : "+s"(l));
  asm volatile("" : "+s"(z));
  const AS4 ParamsD* kd = (const AS4 ParamsD*)((const AS4 char*)__builtin_amdgcn_kernarg_segment_ptr() + z);
  Params p;
  p.x = (const float*)kd->x; p.norm_g = (const float*)kd->norm_g; p.w_in = (const float*)kd->w_in;
  p.a_q_g = (const float*)kd->a_q_g; p.a_k_g = (const float*)kd->a_k_g; p.a_lam = (const float*)kd->a_lam;
  p.a_subln_g = (const float*)kd->a_subln_g; p.b_q_g = (const float*)kd->b_q_g; p.b_k_g = (const float*)kd->b_k_g;
  p.b_cmp_pos = (const float*)kd->b_cmp_pos; p.b_phi_w1 = (const float*)kd->b_phi_w1; p.b_phi_w2 = (const float*)kd->b_phi_w2;
  p.c_w = (const float*)kd->c_w; p.c_scale = (const float*)kd->c_scale; p.w_branch = (const float*)kd->w_branch;
  p.w_out = (const float*)kd->w_out; p.out = (float*)kd->out; p.ws = (char*)kd->ws;
  run_phase<PH>(p, l, smem);
}
__global__ void __launch_bounds__(256, 2) mega_kernel(Params p) {
  __shared__ __attribute__((aligned(16))) char smem[SMEM_BYTES];
  __shared__ int xinfo_s[4];
  volatile int* xinfo = xinfo_s;
  unsigned* bar = (unsigned*)(p.ws + OFF_BAR);
  const unsigned xcc = (unsigned)__builtin_amdgcn_s_getreg((3 << 11) | 20) & 0xFu;
  if (tidx() == 0) xb_add(&bar[64 + 16 * xcc], 1u);
  phase_opaque<0>(0, smem);
  grid_barrier(bar, gridDim.x);
  if (tidx() == 0) {
    int nx = 0, mine = 1;
    for (unsigned j = 0; j < 16; ++j) {
      const unsigned c = xb_ld(&bar[64 + 16 * j]);
      if (c > 0) ++nx;
      if (j == xcc) mine = (int)c;
    }
    xinfo[2] = mine; xinfo[3] = nx;
  }
  __syncthreads();
  phase_opaque<1>(0, smem); xcd_barrier(bar, xcc, xinfo, 1);
  phase_opaque<2>(0, smem); xcd_barrier(bar, xcc, xinfo, 2);
  phase_opaque<3>(0, smem); xcd_barrier(bar, xcc, xinfo, 3);
  phase_opaque<4>(0, smem); xcd_barrier(bar, xcc, xinfo, 4);
  phase_opaque<5>(0, smem); xcd_barrier(bar, xcc, xinfo, 5);
  phase_opaque<0>(1, smem); xcd_barrier(bar, xcc, xinfo, 6);
  phase_opaque<1>(1, smem); xcd_barrier(bar, xcc, xinfo, 7);
  phase_opaque<2>(1, smem); xcd_barrier(bar, xcc, xinfo, 8);
  phase_opaque<3>(1, smem); xcd_barrier(bar, xcc, xinfo, 9);
  phase_opaque<4>(1, smem); xcd_barrier(bar, xcc, xinfo, 10);
  phase_opaque<5>(1, smem);
}
#else
template <int PH>
__global__ void __launch_bounds__(256, 2) phase_kernel(Params p, int l) {
  __shared__ __attribute__((aligned(16))) char smem[SMEM_BYTES];
  run_phase<PH>(p, l, smem);
}
#endif

extern "C" void kernel_launch(void* const* d_in, const int* in_sizes, int n_in, void* d_out, int out_size, void* d_ws,
                              size_t ws_size, hipStream_t stream) {
  if (ws_size < WS_TOTAL) { fprintf(stderr, "workspace too small: %zu < %zu\n", ws_size, (size_t)WS_END); return; }
  Params p{};
  p.x = (const float*)d_in[0]; p.norm_g = (const float*)d_in[1]; p.w_in = (const float*)d_in[2];
  p.a_q_g = (const float*)d_in[3]; p.a_k_g = (const float*)d_in[4]; p.a_lam = (const float*)d_in[5];
  p.a_subln_g = (const float*)d_in[6]; p.b_q_g = (const float*)d_in[7]; p.b_k_g = (const float*)d_in[8];
  p.b_cmp_pos = (const float*)d_in[9]; p.b_phi_w1 = (const float*)d_in[10]; p.b_phi_w2 = (const float*)d_in[11];
  p.c_w = (const float*)d_in[12]; p.c_scale = (const float*)d_in[13]; p.w_branch = (const float*)d_in[14];
  p.w_out = (const float*)d_in[15];
  p.out = (float*)d_out; p.ws = (char*)d_ws;
#if MK_ONE_LAUNCH
  static int grid_blocks = 0;
  if (!grid_blocks) {
    int dev = 0, cus = 0, per_cu = 0;
    (void)hipGetDevice(&dev);
    (void)hipDeviceGetAttribute(&cus, hipDeviceAttributeMultiprocessorCount, dev);
    (void)hipOccupancyMaxActiveBlocksPerMultiprocessor(&per_cu, mega_kernel, 256, 0);
    if (per_cu > 2) per_cu = 2;
    if (per_cu < 1) per_cu = 1;
    grid_blocks = cus * per_cu;
  }
  (void)hipMemsetAsync((char*)d_ws + OFF_BAR, 0, 16384, stream);
  void* args[] = {&p};
  hipError_t e = hipLaunchCooperativeKernel((void*)mega_kernel, dim3(grid_blocks), dim3(256), args, 0, stream);
  if (e != hipSuccess) fprintf(stderr, "cooperative launch failed: %s (grid %d)\n", hipGetErrorString(e), grid_blocks);
#else
  const int G = 512;
  for (int l = 0; l < 2; ++l) {
    phase_kernel<0><<<G, 256, 0, stream>>>(p, l);
    phase_kernel<1><<<G, 256, 0, stream>>>(p, l);
    phase_kernel<2><<<G, 256, 0, stream>>>(p, l);
    phase_kernel<3><<<G, 256, 0, stream>>>(p, l);
    phase_kernel<4><<<G, 256, 0, stream>>>(p, l);
    phase_kernel<5><<<G, 256, 0, stream>>>(p, l);
  }
#endif
}
```
